# Optimizing an MI355X kernel written in HIP

```python
import math
import jax, jax.numpy as jnp
from jax import lax
import numpy as np

D_MODEL = 1024
BATCH = 8
SEQ = 4096
DEPTH = 1

CHUNK = 64
Q_BLOCK = 128
MEM_LEN = 256
EPS = 1e-6

DA_HEADS = 4
DA_QK_DIM = D_MODEL // 16
DA_V_DIM = 2 * DA_QK_DIM
DA_QK_COLS = DA_HEADS * 2 * DA_QK_DIM
DA_WIDTH = DA_HEADS * DA_V_DIM

GLA_HEADS = 4
GLA_K_DIM = D_MODEL // 16
GLA_V_DIM = D_MODEL // 8
GLA_QK_COLS = GLA_HEADS * GLA_K_DIM
GLA_WIDTH = GLA_HEADS * GLA_V_DIM
GLA_GATE_RANK = 16
GLA_TAU = 16.0

MIX_WIDTH = DA_WIDTH + GLA_WIDTH
IN_WIDTH = 2 * DA_QK_COLS + DA_WIDTH + 2 * GLA_QK_COLS + 2 * GLA_WIDTH + GLA_GATE_RANK

CROSS_HEADS = 4
CROSS_DIM = D_MODEL // CROSS_HEADS

N_GROUPS = 4
EXPERTS_PER_GROUP = 8
N_EXPERTS = N_GROUPS * EXPERTS_PER_GROUP
TOP_K = 2
D_EXPERT = D_MODEL // 2
EXPERT_BLOCK = 128

kernel_name = 'hybrid_diffattn_gla_hiermoe_layer'


def _rmsnorm(t, g):
    tf = t.astype(jnp.float32)
    tf = tf * lax.rsqrt(jnp.mean(tf * tf, axis=-1, keepdims=True) + EPS)
    return (tf * g.astype(jnp.float32)).astype(t.dtype)


def _split_heads(t, n):
    b, s, _ = t.shape
    return t.reshape(b, s, n, -1).transpose(0, 2, 1, 3)


def _merge_heads(t):
    b, h, s, d = t.shape
    return t.transpose(0, 2, 1, 3).reshape(b, s, h * d)


def _diff_attention(q1, q2, k1, k2, v, lam):
    b, h, s, d = q1.shape
    n_blocks = s // Q_BLOCK
    scale = d ** -0.5
    key_chunk = jnp.arange(s) // CHUNK

    def to_blocks(t):
        return t.reshape(b, h, n_blocks, Q_BLOCK, d).transpose(2, 0, 1, 3, 4)

    def one_block(args):
        qb1, qb2, bi = args
        q_chunk = (bi * Q_BLOCK + jnp.arange(Q_BLOCK)) // CHUNK
        mask = key_chunk[None, :] <= q_chunk[:, None]

        def probs(qb, kk):
            sc = jnp.einsum('bhqd,bhkd->bhqk', qb, kk).astype(jnp.float32) * scale
            return jax.nn.softmax(jnp.where(mask, sc, -jnp.inf), axis=-1)

        p = probs(qb1, k1) - lam * probs(qb2, k2)
        return jnp.einsum('bhqk,bhkv->bhqv', p.astype(v.dtype), v)

    o = lax.map(one_block, (to_blocks(q1), to_blocks(q2), jnp.arange(n_blocks)))
    return o.transpose(1, 2, 0, 3, 4).reshape(b, h, s, v.shape[-1])


def _gla_chunked(q, k, v, log_a):
    b, h, s, dk = q.shape
    dv = v.shape[-1]
    nc = s // CHUNK
    q = q.reshape(b, h, nc, CHUNK, dk)
    k = k.reshape(b, h, nc, CHUNK, dk)
    v = v.reshape(b, h, nc, CHUNK, dv)
    L = jnp.cumsum(log_a.reshape(b, h, nc, CHUNK, dk), axis=3)
    L_end = L[:, :, :, -1, :]
    Lc = L - L[:, :, :, CHUNK // 2 - 1:CHUNK // 2, :]
    e_pos, e_neg = jnp.exp(Lc), jnp.exp(-Lc)
    a_past = jnp.einsum('bhnid,bhnjd->bhnij', q * e_pos, k * e_neg)
    a_fut = jnp.einsum('bhnid,bhnjd->bhnij', q * e_neg, k * e_pos)
    lower = jnp.tril(jnp.ones((CHUNK, CHUNK), dtype=bool))
    a = jnp.where(lower, a_past, a_fut)
    o_intra = jnp.einsum('bhnij,bhnjv->bhniv', a, v)
    u = jnp.einsum('bhnjd,bhnjv->bhndv', k * jnp.exp(L_end[:, :, :, None, :] - L), v)
    decay = jnp.exp(L_end)

    def step(state, inp):
        d_c, u_c = inp
        return state * d_c[..., None] + u_c, state

    _, s_prev = lax.scan(step, jnp.zeros((b, h, dk, dv), jnp.float32),
                         (jnp.moveaxis(decay, 2, 0), jnp.moveaxis(u, 2, 0)))
    s_prev = jnp.moveaxis(s_prev, 0, 2)
    o_inter = jnp.einsum('bhnid,bhndv->bhniv', q * jnp.exp(L), s_prev)
    return (o_intra + o_inter).reshape(b, h, s, dv)


def _mixer(h, norm_g, w_in, da_qn, da_kn, lq1, lk1, lq2, lk2, da_on, gate_w, gate_b, gla_on, w_o, lam_init):
    b, s, _ = h.shape
    f32 = jnp.float32
    u = _rmsnorm(h, norm_g)
    p = u @ w_in
    widths = (DA_QK_COLS, DA_QK_COLS, DA_WIDTH, GLA_QK_COLS, GLA_QK_COLS, GLA_WIDTH, GLA_WIDTH, GLA_GATE_RANK)
    parts = []
    off = 0
    for w in widths:
        parts.append(p[..., off:off + w])
        off += w
    dq, dk, dv, gq, gk, gv, gg, gr = parts

    dq = dq.reshape(b, s, DA_HEADS, 2, DA_QK_DIM).transpose(0, 2, 3, 1, 4)
    dk = dk.reshape(b, s, DA_HEADS, 2, DA_QK_DIM).transpose(0, 2, 3, 1, 4)
    dq = _rmsnorm(dq, da_qn)
    dk = _rmsnorm(dk, da_kn)
    dvh = _split_heads(dv, DA_HEADS)
    lam = (jnp.exp(jnp.sum(lq1.astype(f32) * lk1.astype(f32)))
           - jnp.exp(jnp.sum(lq2.astype(f32) * lk2.astype(f32))) + lam_init)
    da = _diff_attention(dq[:, :, 0], dq[:, :, 1], dk[:, :, 0], dk[:, :, 1], dvh, lam)
    da = _rmsnorm(da, da_on) * (1.0 - lam_init)
    da_out = _merge_heads(da)

    qg = _split_heads(gq, GLA_HEADS).astype(f32) * (GLA_K_DIM ** -0.5)
    kg = _split_heads(gk, GLA_HEADS).astype(f32)
    vg = _split_heads(gv, GLA_HEADS).astype(f32)
    z = gr.astype(f32) @ gate_w.astype(f32) + gate_b.astype(f32)
    log_a = _split_heads(jax.nn.log_sigmoid(z) / GLA_TAU, GLA_HEADS)
    og = _gla_chunked(qg, kg, vg, log_a)
    og = _rmsnorm(og, gla_on)
    gla_out = (_merge_heads(og) * jax.nn.silu(gg.astype(f32))).astype(h.dtype)

    return jnp.concatenate([da_out.astype(h.dtype), gla_out], axis=-1) @ w_o


def _cross_attention(h, mem, norm_g, norm_m, w_q, w_kv, qn, kn, w_out):
    b, s, d = h.shape
    m = mem.shape[1]
    u = _rmsnorm(h, norm_g)
    mn = _rmsnorm(mem, norm_m)
    q = _rmsnorm((u @ w_q).reshape(b, s, CROSS_HEADS, CROSS_DIM), qn)
    kv = mn @ w_kv
    k = _rmsnorm(kv[..., :d].reshape(b, m, CROSS_HEADS, CROSS_DIM), kn)
    v = kv[..., d:].reshape(b, m, CROSS_HEADS, CROSS_DIM)
    sc = jnp.einsum('bshd,bmhd->bhsm', q, k).astype(jnp.float32) * (CROSS_DIM ** -0.5)
    pr = jax.nn.softmax(sc, axis=-1).astype(v.dtype)
    o = jnp.einsum('bhsm,bmhd->bshd', pr, v).reshape(b, s, d)
    return o @ w_out


def _hier_moe(h, norm_g, w_group, b_group, w_expert, b_expert, w_gate, w_up, w_down):
    b, s, d = h.shape
    t = b * s
    f32 = jnp.float32
    xf = _rmsnorm(h, norm_g).reshape(t, d)
    xr = xf.astype(f32)
    p_group = jax.nn.softmax(xr @ w_group.astype(f32) + b_group.astype(f32), axis=-1)
    g_sel = jnp.argmax(p_group, axis=-1)
    p_g = jnp.take_along_axis(p_group, g_sel[:, None], axis=-1)
    e_logits = (xr @ w_expert.astype(f32) + b_expert.astype(f32)).reshape(t, N_GROUPS, EXPERTS_PER_GROUP)
    e_logits = jnp.take_along_axis(e_logits, g_sel[:, None, None], axis=1)[:, 0]
    top_p, top_i = lax.top_k(jax.nn.softmax(e_logits, axis=-1), TOP_K)
    gate = p_g * top_p / jnp.sum(top_p, axis=-1, keepdims=True)
    flat_id = (g_sel[:, None] * EXPERTS_PER_GROUP + top_i).reshape(-1).astype(jnp.int32)
    flat_gate = gate.reshape(-1)
    n_assign = t * TOP_K
    order = jnp.argsort(flat_id)
    sorted_id = flat_id[order]
    token_of = order // TOP_K
    sizes = jnp.bincount(flat_id, length=N_EXPERTS)
    padded = (sizes + EXPERT_BLOCK - 1) // EXPERT_BLOCK * EXPERT_BLOCK
    start = jnp.cumsum(sizes) - sizes
    padded_end = jnp.cumsum(padded)
    padded_start = padded_end - padded
    dest = padded_start[sorted_id] + jnp.arange(n_assign) - start[sorted_id]
    n_rows = n_assign + N_EXPERTS * EXPERT_BLOCK
    n_blocks = n_rows // EXPERT_BLOCK
    x_pad = jnp.zeros((n_rows, d), xf.dtype).at[dest].set(xf[token_of])
    block_expert = jnp.minimum(
        jnp.searchsorted(padded_end, jnp.arange(n_blocks) * EXPERT_BLOCK, side='right'), N_EXPERTS - 1)

    def expert_block(args):
        xb, e = args
        hid = jax.nn.silu(xb @ w_gate[e]) * (xb @ w_up[e])
        return hid @ w_down[e]

    out_pad = lax.map(expert_block, (x_pad.reshape(n_blocks, EXPERT_BLOCK, d), block_expert)).reshape(n_rows, d)
    out = out_pad[dest] * flat_gate[order][:, None].astype(out_pad.dtype)
    y = jnp.zeros((t, d), out.dtype).at[token_of].add(out)
    return y.reshape(b, s, d).astype(h.dtype)


def setup_inputs(seed: int = 0) -> dict:
    key = jax.random.key(seed)
    ks = iter(jax.random.split(key, 40))
    f32 = jnp.float32
    D = D_MODEL

    def nrm(shape, scale):
        return scale * jax.random.normal(next(ks), shape, f32)

    def gain(n):
        return 1.0 + 0.02 * jax.random.normal(next(ks), (DEPTH, n), f32)

    return {
        'x': nrm((BATCH, SEQ, D), 1.0),
        'mem': nrm((BATCH, MEM_LEN, D), 1.0),
        'norm_mix': gain(D),
        'w_in': nrm((DEPTH, D, IN_WIDTH), D ** -0.5),
        'da_q_norm': gain(DA_QK_DIM),
        'da_k_norm': gain(DA_QK_DIM),
        'lambda_q1': nrm((DEPTH, DA_QK_DIM), 0.1),
        'lambda_k1': nrm((DEPTH, DA_QK_DIM), 0.1),
        'lambda_q2': nrm((DEPTH, DA_QK_DIM), 0.1),
        'lambda_k2': nrm((DEPTH, DA_QK_DIM), 0.1),
        'da_out_norm': gain(DA_V_DIM),
        'gla_gate_w': nrm((DEPTH, GLA_GATE_RANK, GLA_QK_COLS), GLA_GATE_RANK ** -0.5),
        'gla_gate_b': nrm((DEPTH, GLA_QK_COLS), 0.1),
        'gla_out_norm': gain(GLA_V_DIM),
        'w_o': nrm((DEPTH, MIX_WIDTH, D), MIX_WIDTH ** -0.5),
        'norm_cross': gain(D),
        'norm_mem': gain(D),
        'w_cq': nrm((DEPTH, D, D), D ** -0.5),
        'w_ckv': nrm((DEPTH, D, 2 * D), D ** -0.5),
        'cross_q_norm': gain(CROSS_DIM),
        'cross_k_norm': gain(CROSS_DIM),
        'w_co': nrm((DEPTH, D, D), D ** -0.5),
        'norm_ffn': gain(D),
        'w_group': nrm((DEPTH, D, N_GROUPS), D ** -0.5),
        'b_group': nrm((DEPTH, N_GROUPS), 0.01),
        'w_expert': nrm((DEPTH, D, N_EXPERTS), D ** -0.5),
        'b_expert': nrm((DEPTH, N_EXPERTS), 0.01),
        'w_e_gate': nrm((DEPTH, N_EXPERTS, D, D_EXPERT), D ** -0.5),
        'w_e_up': nrm((DEPTH, N_EXPERTS, D, D_EXPERT), D ** -0.5),
        'w_e_down': nrm((DEPTH, N_EXPERTS, D_EXPERT, D), D_EXPERT ** -0.5),
    }


def reference(x, mem, norm_mix, w_in, da_q_norm, da_k_norm, lambda_q1, lambda_k1, lambda_q2, lambda_k2,
              da_out_norm, gla_gate_w, gla_gate_b, gla_out_norm, w_o, norm_cross, norm_mem, w_cq, w_ckv,
              cross_q_norm, cross_k_norm, w_co, norm_ffn, w_group, b_group, w_expert, b_expert,
              w_e_gate, w_e_up, w_e_down):
    h = x
    for l in range(DEPTH):
        lam_init = 0.8 - 0.6 * math.exp(-0.3 * l)
        h = h + _mixer(h, norm_mix[l], w_in[l], da_q_norm[l], da_k_norm[l], lambda_q1[l], lambda_k1[l],
                       lambda_q2[l], lambda_k2[l], da_out_norm[l], gla_gate_w[l], gla_gate_b[l],
                       gla_out_norm[l], w_o[l], lam_init)
        h = h + _cross_attention(h, mem, norm_cross[l], norm_mem[l], w_cq[l], w_ckv[l],
                                 cross_q_norm[l], cross_k_norm[l], w_co[l])
        h = h + _hier_moe(h, norm_ffn[l], w_group[l], b_group[l], w_expert[l], b_expert[l],
                          w_e_gate[l], w_e_up[l], w_e_down[l])
    return h
```

```cpp
#include <hip/hip_runtime.h>
#include <cstdio>
#include <cstdint>
#include <cstring>
#include <cmath>
#ifndef PROBE
#define PROBE -1
#endif

#define GAS __attribute__((address_space(1)))
#define LAS __attribute__((address_space(3)))
typedef unsigned short bf16;
typedef unsigned v4u __attribute__((ext_vector_type(4)));
typedef unsigned v2u __attribute__((ext_vector_type(2)));
typedef float f32x4 __attribute__((ext_vector_type(4)));
typedef float f32x16 __attribute__((ext_vector_type(16)));
typedef short bf16x8 __attribute__((ext_vector_type(8)));
typedef int i32x4 __attribute__((ext_vector_type(4)));
typedef GAS unsigned gu32;
#define RLX_AGENT __ATOMIC_RELAXED, __HIP_MEMORY_SCOPE_AGENT
#define LDS_WAIT() asm volatile("s_waitcnt lgkmcnt(0)" ::: "memory")
#define VM_WAIT() asm volatile("s_waitcnt vmcnt(0)" ::: "memory")
__device__ __forceinline__ unsigned f2bf(float f) { unsigned u = __builtin_bit_cast(unsigned, f); return (u + 0x7fffu + ((u >> 16) & 1u)) >> 16; }
__device__ __forceinline__ unsigned pk2(float lo, float hi) { return f2bf(lo) | (f2bf(hi) << 16); }
__device__ __forceinline__ float bf2f(unsigned short b) { return __builtin_bit_cast(float, ((unsigned)b) << 16); }
typedef float f32x2_t __attribute__((ext_vector_type(2))); typedef __bf16 bf16x2_t __attribute__((ext_vector_type(2)));
__device__ __forceinline__ unsigned cvtpk_s(float lo, float hi) { f32x2_t v = {lo, hi}; bf16x2_t b = __builtin_convertvector(v, bf16x2_t); return __builtin_bit_cast(unsigned, b); }
__device__ __forceinline__ unsigned cvt_pk_bf16(float lo, float hi) { return cvtpk_s(lo, hi); }

namespace pg8 {
constexpr int BM = 256, BK = 64, HALF = 128, HTB = HALF * BK * 2, STAGE_BYTES = 8 * HTB;
__host__ __device__ __forceinline__ int lds_byte(int r, int c) { const int st = (r >> 4) * 2 + (c >> 5), rr = r & 15, cc = c & 31, ob = rr * 64 + cc * 2; return st * 1024 + (ob ^ (((ob >> 9) & 1) << 5)); }
__host__ __device__ __forceinline__ void stage_rc(int b, int& R, int& C) { const int st = b / 1024, sb = b % 1024, swz = sb ^ (((sb >> 9) & 1) << 5); R = (st >> 1) * 16 + swz / 64; C = (st & 1) * 32 + (swz % 64) / 2; }
__host__ __device__ __forceinline__ int perm32(int rho) { const int n = rho >> 4, i = rho & 15; return 8 * (i >> 2) + 4 * n + (i & 3); }

template <class Epi, class Sched, bool GATHER, bool I8 = false>
__device__ __forceinline__ void gemm_phase(LAS unsigned char* lds, LAS unsigned char* idxlds  , const int lda, const int ldb, const int K, const Sched& S, const Epi& E) {
    int tid_ = threadIdx.x; asm volatile("" : "+v"(tid_));
    const int tid = tid_, wid = __builtin_amdgcn_readfirstlane(tid >> 6), lane = tid & 63, wr = wid >> 2, wc = wid & 3, fr = lane & 15, fq = lane >> 4;
    const int nt = K / BK;
    int Rr[2], Cb[2]; unsigned voffB[2];
#pragma unroll
    for (int i = 0; i < 2; ++i) { int R, C; stage_rc(tid * 16 + i * 8192, R, C); const int Rb = Epi::PERM ? ((R & ~31) + perm32(R & 31)) : R; Rr[i] = R; Cb[i] = C * 2; voffB[i] = (unsigned)(Rb * ldb + C * 2); }
    const size_t kstep = (size_t)(BK * 2);
    const size_t hstepB = (size_t)HALF * ldb, hstepA = (size_t)HALF * lda;
    const unsigned ldsw = (unsigned)wid * 1024u;
    const int aoff = lds_byte(wr * 64 + fr, fq * 8), boff = lds_byte(wc * 32 + fr, fq * 8);
#define PG8_SA(b, h) (((b) * 2 + (h)) * HTB)
#define PG8_SB(b, h) ((4 + (b) * 2 + (h)) * HTB)
#define PG8_STG_B(bufoff, gbase, h) do { _Pragma("unroll") for (int _i = 0; _i < 2; ++_i) \
        __builtin_amdgcn_global_load_lds((const unsigned*)((const char*)(gbase) + (size_t)(h) * hstepB + voffB[_i]), (LAS unsigned*)(lds + (bufoff) + ldsw + _i * 8192), 16, 0, 0); } while (0)
#define PG8_STG_A(bufoff, gbase, h, OA) do { _Pragma("unroll") for (int _i = 0; _i < 2; ++_i) \
        __builtin_amdgcn_global_load_lds((const unsigned*)((const char*)(gbase) + (GATHER ? (size_t)0 : (size_t)(h) * hstepA) + (OA)[GATHER ? (h) : 0][_i]), (LAS unsigned*)(lds + (bufoff) + ldsw + _i * 8192), 16, 0, 0); } while (0)
#define PG8_LDA(dst, b, h) do { _Pragma("unroll") for (int m = 0; m < 4; ++m) _Pragma("unroll") for (int k = 0; k < 2; ++k) dst[m][k] = *(const LAS bf16x8*)(lds + PG8_SA(b, h) + aoff + m * 2048 + k * 1024); } while (0)
#define PG8_LDB(dst, b, h) do { _Pragma("unroll") for (int n = 0; n < 2; ++n) _Pragma("unroll") for (int k = 0; k < 2; ++k) dst[n][k] = *(const LAS bf16x8*)(lds + PG8_SB(b, h) + boff + n * 2048 + k * 1024); } while (0)
#define PG8_MMA(ai, bj, At, Bt) do { __builtin_amdgcn_s_setprio(1); _Pragma("unroll") for (int m = 0; m < 4; ++m) _Pragma("unroll") for (int n = 0; n < 2; ++n) _Pragma("unroll") for (int k = 0; k < 2; ++k) \
        { if constexpr (I8) acc[ai][bj][m][n] = __builtin_bit_cast(f32x4, __builtin_amdgcn_mfma_i32_16x16x64_i8(__builtin_bit_cast(i32x4, Bt[n][k]), __builtin_bit_cast(i32x4, At[m][k]), __builtin_bit_cast(i32x4, acc[ai][bj][m][n]), 0, 0, 0)); \
          else acc[ai][bj][m][n] = __builtin_amdgcn_mfma_f32_16x16x32_bf16(Bt[n][k], At[m][k], acc[ai][bj][m][n], 0, 0, 0); } __builtin_amdgcn_s_setprio(0); } while (0)
#define PG8_WAIT_V(n) asm volatile("s_waitcnt vmcnt(" #n ")" ::: "memory")
#define PG8_WAIT_L(n) asm volatile("s_waitcnt lgkmcnt(" #n ")" ::: "memory")
#define PG8_BAR __builtin_amdgcn_s_barrier()
#define PG8_SCHED __builtin_amdgcn_sched_barrier(0)
    typename Sched::Unit cur, nxt; int ui = 0;
    if (!S.next(0, cur)) return;
    f32x4 acc[2][2][4][2];
#pragma unroll
    for (int a = 0; a < 2; ++a)
#pragma unroll
        for (int b = 0; b < 2; ++b)
#pragma unroll
            for (int m = 0; m < 4; ++m)
#pragma unroll
                for (int n = 0; n < 2; ++n) acc[a][b][m][n] = (f32x4){0.f, 0.f, 0.f, 0.f};
    bf16x8 At[4][2], B0[2][2], B1[2][2];
    unsigned offA[2][2], offN[2][2];
    if constexpr (GATHER) { const int* ix = S.idx(cur);
#pragma unroll
        for (int h = 0; h < 2; ++h)
#pragma unroll
            for (int i = 0; i < 2; ++i) offA[h][i] = (unsigned)ix[Rr[i] + HALF * h] * (unsigned)lda + (unsigned)Cb[i];
    } else {
#pragma unroll
        for (int h = 0; h < 2; ++h)
#pragma unroll
            for (int i = 0; i < 2; ++i) offA[h][i] = (unsigned)Rr[i] * (unsigned)lda + (unsigned)Cb[i];
    }
    if constexpr (GATHER) {
#pragma unroll
    for (int h = 0; h < 2; ++h)
#pragma unroll
        for (int i = 0; i < 2; ++i) offN[h][i] = offA[h][i]; }
    const char* cA = S.pa(cur); const char* cB = S.pb(cur);
    PG8_STG_B(PG8_SB(0, 0), cB, 0); PG8_STG_B(PG8_SB(0, 1), cB, 1); PG8_STG_A(PG8_SA(0, 0), cA, 0, offA); PG8_STG_A(PG8_SA(0, 1), cA, 1, offA);
    if (wr == 1) PG8_BAR;
    PG8_WAIT_V(2); PG8_BAR;
    PG8_STG_B(PG8_SB(1, 0), cB + kstep, 0); PG8_STG_A(PG8_SA(1, 0), cA + kstep, 0, offA); PG8_STG_B(PG8_SB(1, 1), cB + kstep, 1);
    PG8_WAIT_V(6); PG8_BAR;
    for (;;) {
        const bool has_next = S.next(ui + 1, nxt);
        const char* nA = has_next ? S.pa(nxt) : cA; const char* nB = has_next ? S.pb(nxt) : cB;
        if constexpr (GATHER) { if (has_next && wid == 0) {
            __builtin_amdgcn_global_load_lds((const unsigned*)((const char*)S.idx(nxt) + lane * 16), (LAS unsigned*)(idxlds + ((ui + 1) & 1) * 1024), 16, 0, 0); } }
        for (int t = 0; t < nt; t += 2) {
            const bool last = (t == nt - 2);
            const char* a1 = cA + (size_t)(t + 1) * kstep;
            const char* a2 = last ? nA : cA + (size_t)(t + 2) * kstep; const char* b2 = last ? nB : cB + (size_t)(t + 2) * kstep;
            const char* a3 = a2 + kstep; const char* b3 = b2 + kstep;
            unsigned o2s[2][2];
            const unsigned (&o2)[2][2] = *(GATHER ? &o2s : &offA);
            if constexpr (GATHER) {
                if (last && has_next) { const LAS int* ix = (const LAS int*)(idxlds + ((ui + 1) & 1) * 1024);
#pragma unroll
                    for (int h = 0; h < 2; ++h)
#pragma unroll
                        for (int i = 0; i < 2; ++i) offN[h][i] = (unsigned)ix[Rr[i] + HALF * h] * (unsigned)lda + (unsigned)Cb[i]; }
#pragma unroll
                for (int h = 0; h < 2; ++h)
#pragma unroll
                    for (int i = 0; i < 2; ++i) o2s[h][i] = last ? offN[h][i] : offA[h][i];
            }
            PG8_LDB(B0, 0, 0); PG8_LDB(B1, 0, 1); PG8_SCHED; PG8_LDA(At, 0, 0); PG8_STG_A(PG8_SA(1, 1), a1, 1, offA);
            PG8_WAIT_V(8); PG8_WAIT_L(0); PG8_BAR; PG8_MMA(0, 0, At, B0); PG8_MMA(0, 1, At, B1); PG8_BAR; PG8_SCHED;
            PG8_LDA(At, 0, 1); PG8_STG_B(PG8_SB(0, 0), b2, 0); PG8_STG_B(PG8_SB(0, 1), b2, 1); PG8_STG_A(PG8_SA(0, 0), a2, 0, o2);
            PG8_WAIT_V(8); PG8_WAIT_L(0); PG8_BAR; PG8_MMA(1, 0, At, B0); PG8_MMA(1, 1, At, B1); PG8_BAR; PG8_SCHED;
            PG8_LDB(B0, 1, 0); PG8_LDB(B1, 1, 1); PG8_SCHED; PG8_LDA(At, 1, 0); PG8_STG_A(PG8_SA(0, 1), a2, 1, o2);
            PG8_WAIT_V(8); PG8_WAIT_L(0); PG8_BAR; PG8_MMA(0, 0, At, B0); PG8_MMA(0, 1, At, B1); PG8_BAR; PG8_SCHED;
            PG8_LDA(At, 1, 1); PG8_STG_B(PG8_SB(1, 0), b3, 0); PG8_STG_B(PG8_SB(1, 1), b3, 1); PG8_STG_A(PG8_SA(1, 0), a3, 0, o2);
            PG8_WAIT_V(8); PG8_WAIT_L(0); PG8_BAR; PG8_MMA(1, 0, At, B0); PG8_MMA(1, 1, At, B1); PG8_BAR; PG8_SCHED;
        }
        if (wr == 0) PG8_BAR;
        { int t_e = threadIdx.x; asm volatile("" : "+v"(t_e));
          E(acc, cur, wr, wc, t_e & 15, (t_e & 63) >> 4); }
        if (!has_next) break;
#pragma unroll
        for (int a = 0; a < 2; ++a)
#pragma unroll
            for (int b = 0; b < 2; ++b)
#pragma unroll
                for (int m = 0; m < 4; ++m)
#pragma unroll
                    for (int n = 0; n < 2; ++n) acc[a][b][m][n] = (f32x4){0.f, 0.f, 0.f, 0.f};
        cur = nxt; cA = nA; cB = nB; ++ui;
        if constexpr (GATHER) {
#pragma unroll
        for (int h = 0; h < 2; ++h)
#pragma unroll
            for (int i = 0; i < 2; ++i) offA[h][i] = offN[h][i]; }
        if (wr == 1) PG8_BAR;
    }
    PG8_WAIT_V(0);
    PG8_BAR;
#undef PG8_SA
#undef PG8_SB
#undef PG8_STG_A
#undef PG8_STG_B
#undef PG8_LDA
#undef PG8_LDB
#undef PG8_MMA
#undef PG8_WAIT_V
#undef PG8_WAIT_L
#undef PG8_BAR
#undef PG8_SCHED
}
}

#define XB_TMO      128
#define XB_XCNT(j)  (256  + 64 * (j))
#define XB_XSUB(j)  (1280 + 64 * (j))
#define XB_XGEN(j)  (2304 + 64 * (j))
#define XB_TOP      3328
#define XB_TOPGEN   3392
#define XCD_BAR_WORDS 3456
#define XB_SPIN_CAP (1u << 22)

__device__ __forceinline__ unsigned xb_ld(unsigned* p)              { return __hip_atomic_load(p, __ATOMIC_RELAXED, __HIP_MEMORY_SCOPE_AGENT); }
__device__ __forceinline__ unsigned xb_add(unsigned* p, unsigned v) { return __hip_atomic_fetch_add(p, v, __ATOMIC_RELAXED, __HIP_MEMORY_SCOPE_AGENT); }
__device__ __forceinline__ unsigned xb_xcc_id() { return (unsigned)__builtin_amdgcn_s_getreg((3 << 11) | 20) & 0xFu; }
#define XB_SPIN(cond, bar) do { unsigned _sp = 0; while (cond) { __builtin_amdgcn_s_sleep(1); \
    if ((++_sp & 255u) == 0u) { if (xb_ld(&(bar)[XB_TMO])) break; if (_sp > XB_SPIN_CAP) { atomicAdd(&(bar)[XB_TMO], 1u); break; } } } } while (0)

struct XcdBarrier {
    unsigned* bar; unsigned x;
    volatile LAS unsigned* st;
};

__device__ __forceinline__ XcdBarrier xcd_barrier_post(unsigned* bar, volatile LAS unsigned* st) {
    XcdBarrier b; b.bar = bar; b.x = xb_xcc_id(); b.st = st;
    if (threadIdx.x == 0) (void)xb_add(&bar[XB_XCNT(b.x)], 1u);
    return b;
}
__device__ __forceinline__ void xcd_barrier_complete(unsigned* bar, unsigned x, unsigned& nloc, unsigned& nx) {
    const unsigned G = gridDim.x * gridDim.y * gridDim.z;
    unsigned sum, cnt, mine, sp = 0u;
    for (;;) {
        sum = 0u; cnt = 0u; mine = 0u;
#pragma unroll
        for (unsigned j = 0; j < 16; ++j) { const unsigned c = xb_ld(&bar[XB_XCNT(j)]); sum += c; cnt += (c > 0u) ? 1u : 0u; mine = (j == x) ? c : mine; }
        if (sum == G) break;
        __builtin_amdgcn_s_sleep(1);
        if ((++sp & 255u) == 0u) { if (xb_ld(&bar[XB_TMO])) break; if (sp > XB_SPIN_CAP) { atomicAdd(&bar[XB_TMO], 1u); break; } }
    }
    nloc = mine > 0u ? mine : 1u; nx = cnt > 0u ? cnt : 1u;
}

__device__ __forceinline__ void xcd_barrier(const XcdBarrier& b) {
    asm volatile("s_waitcnt vmcnt(0)" ::: "memory");
    __syncthreads();
    if (threadIdx.x == 0) {
        unsigned* bar = b.bar;
        __builtin_amdgcn_s_waitcnt(0);
        unsigned nloc = b.st[0], nx = b.st[1];
        if (nloc == 0u) { xcd_barrier_complete(bar, b.x, nloc, nx); b.st[0] = nloc; b.st[1] = nx; }
        const unsigned old = xb_add(&bar[XB_XSUB(b.x)], 1u);
        const unsigned gen = old / nloc;
        if (old + 1u == (gen + 1u) * nloc) {
            __builtin_amdgcn_fence(__ATOMIC_RELEASE, "agent");
            asm volatile("s_waitcnt vmcnt(0)" ::: "memory");
            const unsigned og = xb_add(&bar[XB_TOP], 1u);
            const unsigned tg = og / nx;
            if (og + 1u == (tg + 1u) * nx) xb_add(&bar[XB_TOPGEN], 1u);
            else XB_SPIN(xb_ld(&bar[XB_TOPGEN]) == tg, bar);
            __builtin_amdgcn_fence(__ATOMIC_ACQUIRE, "agent");
            xb_add(&bar[XB_XGEN(b.x)], 1u);
            asm volatile("s_waitcnt vmcnt(0)" ::: "memory");
        } else {
            XB_SPIN(xb_ld(&bar[XB_XGEN(b.x)]) == gen, bar);
            __builtin_amdgcn_fence(__ATOMIC_ACQUIRE, "agent");
            asm volatile("s_waitcnt vmcnt(0)" ::: "memory");
        }
    }
    __syncthreads();
}

constexpr int NWAVES = 8;
constexpr int NB = 8, SEQ = 4096, D = 1024, T = NB * SEQ, MEML = 256, TM = NB * MEML, INW = 3088;
constexpr float EPS = 1e-6f;
constexpr float LOG2E = 1.4426950408889634f;
constexpr float QSCALE = 0.125f * LOG2E;
constexpr float LAM_INIT = 0.2f;
constexpr size_t MiB = 1u << 20;
constexpr size_t WS_CTL = 0, CTL_ZERO_BYTES = 1 * MiB;
constexpr size_t WS_WIN = 1 * MiB;
constexpr size_t WS_WO = WS_WIN + 6 * MiB;
constexpr size_t WS_WCQ = WS_WO + 2 * MiB;
constexpr size_t WS_WCKV = WS_WCQ + 2 * MiB;
constexpr size_t WS_WCO = WS_WCKV + 4 * MiB;
constexpr size_t WS_WGU = WS_WCO + 2 * MiB;
constexpr size_t WS_WD = WS_WGU + 64 * MiB;
constexpr size_t WS_MN = WS_WD + 32 * MiB;
constexpr size_t WS_KC = WS_MN + 4 * MiB;
constexpr size_t WS_VCT = WS_KC + 4 * MiB;
constexpr size_t WS_GR = WS_VCT + 4 * MiB;
constexpr size_t WS_RA = WS_GR + 2 * MiB;
constexpr size_t WS_RB = WS_RA + 64 * MiB;
constexpr size_t WS_RC = WS_RB + 96 * MiB;
constexpr size_t WS_RD = WS_RC + 96 * MiB;
constexpr size_t WS_LIST = WS_RD + 96 * MiB;
constexpr size_t WS_GATE = WS_LIST + 8 * MiB;
constexpr size_t WS_RSTD = WS_GATE + 8 * MiB;
constexpr size_t WS_RSUM = WS_RSTD + 1 * MiB;
constexpr size_t WS_SSQ1 = WS_RSUM + 2 * MiB;
constexpr size_t WS_SSQ2 = WS_SSQ1 + 1 * MiB;
constexpr size_t WS_TOKPOS = WS_SSQ2 + 1 * MiB;
constexpr size_t WS_WR = WS_TOKPOS + 1 * MiB;
constexpr size_t WS_SA = WS_WR + 1 * MiB;
constexpr size_t WS_SB = WS_SA + 512 * 1024;
constexpr size_t WS_SBGU = WS_SA + 640 * 1024;
constexpr size_t WS_END = WS_SA + 1 * MiB;
static_assert(WS_END <= 512 * MiB, "workspace");
constexpr int CAP = 32768;
constexpr int CW_Q = 2048;
constexpr int CW_CNT = 8192;
constexpr int CW_BAR = 4096;
constexpr int RING_OFF = 0, RING_BYTES = 131072;
constexpr int XCH_OFF = RING_BYTES;
constexpr int TAB_OFF = XCH_OFF + 4096;
constexpr int IDX_OFF = TAB_OFF + 1024;
constexpr int MISC_OFF = IDX_OFF + 2048;
constexpr int LDS_BYTES = 147456;
static_assert(MISC_OFF + 256 <= LDS_BYTES, "LDS map");

struct Frame {
    LAS unsigned char* lds;
    int tid, lane, wave, vcu, G;
};
__device__ __forceinline__ float wave_sum(float v) {
#pragma unroll
    for (int o = 1; o < 64; o <<= 1) v += __shfl_xor(v, o);
    return v;
}
template <class RM> __device__ __forceinline__ void tr_item(const float* __restrict__ W, int ldw, int c0, int K, int ncols, bf16* WT, const float* __restrict__ gain, RM rm, LAS float* scr, int item, int lane) {
    const int nblk = ncols / 32, kb = item / nblk, nb = item % nblk, k0 = 64 * kb, n0 = 32 * nb;
    const int r = lane >> 3, c4 = lane & 7;
    f32x4 w[8];
#pragma unroll
    for (int i = 0; i < 8; ++i) w[i] = *(const GAS f32x4*)(W + (size_t)(k0 + 8 * i + r) * ldw + c0 + n0 + 4 * c4);
#pragma unroll
    for (int i = 0; i < 8; ++i) { const int k = 8 * i + r; f32x4 v = w[i]; if (gain) v = v * gain[k0 + k]; *(LAS f32x4*)(scr + k * 36 + (k >> 5) * 32 + 4 * c4) = v; }
    LDS_WAIT(); asm volatile("" ::: "memory");
    const int n = lane & 31, kh = lane >> 5; const LAS float* s = scr + (32 * kh) * 36 + kh * 32 + n;
    unsigned pk[16];
#pragma unroll
    for (int j = 0; j < 16; ++j) pk[j] = pk2(s[(2 * j) * 36], s[(2 * j + 1) * 36]);
    GAS v4u* dst = (GAS v4u*)(WT + (size_t)rm(n0 + n) * K + k0 + 32 * kh);
#pragma unroll
    for (int j = 0; j < 4; ++j) dst[j] = (v4u){pk[4 * j], pk[4 * j + 1], pk[4 * j + 2], pk[4 * j + 3]};
    LDS_WAIT(); asm volatile("" ::: "memory");
}
struct TrDesc { const float* W; const float* gain; bf16* WT; int ldw, K, nblk, kind, base, r; };
__device__ __forceinline__ void tr_load(const TrDesc& d, int lane, f32x4 (&w)[8], float (&gk)[8]) {
    const int kb = d.r / d.nblk, nb = d.r % d.nblk, k0 = 64 * kb, n0 = 32 * nb, r = lane >> 3, c4 = lane & 7;
#pragma unroll
    for (int i = 0; i < 8; ++i) { w[i] = *(const GAS f32x4*)(d.W + (size_t)(k0 + 8 * i + r) * d.ldw + n0 + 4 * c4); gk[i] = d.gain ? d.gain[k0 + 8 * i + r] : 1.f; }
}
__device__ __forceinline__ void tr_finish(const TrDesc& d, int lane, const f32x4 (&w)[8], const float (&gk)[8], LAS float* scr) {
    const int kb = d.r / d.nblk, nb = d.r % d.nblk, k0 = 64 * kb, n0 = 32 * nb, r = lane >> 3, c4 = lane & 7;
#pragma unroll
    for (int i = 0; i < 8; ++i) { const int k = 8 * i + r; *(LAS f32x4*)(scr + k * 36 + (k >> 5) * 32 + 4 * c4) = w[i] * gk[i]; }
    LDS_WAIT(); asm volatile("" ::: "memory");
    const int n = lane & 31, kh = lane >> 5; const LAS float* sp = scr + (32 * kh) * 36 + kh * 32 + n;
    unsigned pk[16];
#pragma unroll
    for (int j = 0; j < 16; ++j) pk[j] = cvtpk_s(sp[(2 * j) * 36], sp[(2 * j + 1) * 36]);
    const int nn = n0 + n; int row;
    if (d.kind == 0) row = d.base + nn;
    else if (d.kind == 1) { if (nn >= 1024) row = nn; else { const int c = nn & 255, wc = c >> 6, bj = (c >> 5) & 1, j = c & 31; row = (nn & ~255) + 128 * bj + 32 * wc + j; } }
    else row = d.base + (nn >> 7) * 256 + (nn & 127);
    GAS v4u* dst = (GAS v4u*)(d.WT + (size_t)row * d.K + k0 + 32 * kh);
#pragma unroll
    for (int j = 0; j < 4; ++j) dst[j] = (v4u){pk[4 * j], pk[4 * j + 1], pk[4 * j + 2], pk[4 * j + 3]};
    LDS_WAIT(); asm volatile("" ::: "memory");
}
struct RmPlain { int off; __device__ __forceinline__ int operator()(int n) const { return off + n; } };
struct RmIn { __device__ __forceinline__ int operator()(int n) const { if (n >= 1024) return n; const int c = n & 255, wc = c >> 6, bj = (c >> 5) & 1, j = c & 31; return (n & ~255) + 128 * bj + 32 * wc + j; } };
struct RmGU { int base; __device__ __forceinline__ int operator()(int n) const { return base + (n >> 7) * 256 + (n & 127); } };

constexpr int TR_I_IN = 16 * 96, TR_I_SQ = 16 * 32, TR_I_CKV = 16 * 64, TR_I_E = 16 * 16, TR_I_D = 8 * 32;
constexpr int TR_NONEXPERT = TR_I_IN + 3 * TR_I_SQ + TR_I_CKV, TR_NITEMS = TR_NONEXPERT + 32 * (2 * TR_I_E + TR_I_D);
__device__ __forceinline__ TrDesc tr_mkdesc(const float* const* in, unsigned char* ws, int it) { TrDesc d; int r = it; d.gain = nullptr; d.kind = 0; d.base = 0;
    if (r < TR_I_IN) { d.W = in[3]; d.ldw = INW; d.K = D; d.nblk = 96; d.WT = (bf16*)(ws + WS_WIN); d.kind = 1; d.r = r; return d; } r -= TR_I_IN;
    if (r < TR_I_SQ) { d.W = in[14]; d.ldw = D; d.K = D; d.nblk = 32; d.WT = (bf16*)(ws + WS_WO); d.r = r; return d; } r -= TR_I_SQ;
    if (r < TR_I_SQ) { d.W = in[17]; d.ldw = D; d.K = D; d.nblk = 32; d.WT = (bf16*)(ws + WS_WCQ); d.gain = in[15]; d.r = r; return d; } r -= TR_I_SQ;
    if (r < TR_I_CKV) { d.W = in[18]; d.ldw = 2 * D; d.K = D; d.nblk = 64; d.WT = (bf16*)(ws + WS_WCKV); d.r = r; return d; } r -= TR_I_CKV;
    if (r < TR_I_SQ) { d.W = in[21]; d.ldw = D; d.K = D; d.nblk = 32; d.WT = (bf16*)(ws + WS_WCO); d.r = r; return d; } r -= TR_I_SQ;
    const int e = r / (2 * TR_I_E + TR_I_D); r -= e * (2 * TR_I_E + TR_I_D);
    if (r < TR_I_E) { d.W = in[27] + (size_t)e * D * 512; d.ldw = 512; d.K = D; d.nblk = 16; d.WT = (bf16*)(ws + WS_WGU); d.gain = in[22]; d.kind = 2; d.base = e * 1024; d.r = r; return d; } r -= TR_I_E;
    if (r < TR_I_E) { d.W = in[28] + (size_t)e * D * 512; d.ldw = 512; d.K = D; d.nblk = 16; d.WT = (bf16*)(ws + WS_WGU); d.gain = in[22]; d.kind = 2; d.base = e * 1024 + 128; d.r = r; return d; } r -= TR_I_E;
    d.W = in[29] + (size_t)e * 512 * D; d.ldw = D; d.K = 512; d.nblk = 32; d.WT = (bf16*)(ws + WS_WD); d.base = e * 1024; d.r = r; return d; }
__device__ __forceinline__ void tr_run(const float* const* in, unsigned char* ws, LAS float* scr, int lane, int first, int step, int last) {
    int it = first; TrDesc da_, db_; f32x4 wa[8], wb[8]; float ga[8], gb[8];
    if (it < last) { da_ = tr_mkdesc(in, ws, it); tr_load(da_, lane, wa, ga); }
    while (it < last) {
        const int i1 = it + step; if (i1 < last) { db_ = tr_mkdesc(in, ws, i1); tr_load(db_, lane, wb, gb); }
        tr_finish(da_, lane, wa, ga, scr);
        if (i1 >= last) break;
        const int i2 = i1 + step; if (i2 < last) { da_ = tr_mkdesc(in, ws, i2); tr_load(da_, lane, wa, ga); }
        tr_finish(db_, lane, wb, gb, scr);
        it = i2; }
}
__device__ __forceinline__ unsigned pack_i8x4(float a, float b, float c, float d) {
    const int ia = (int)rintf(a), ib = (int)rintf(b), ic = (int)rintf(c), id = (int)rintf(d);
    return (unsigned)(ia & 255) | ((unsigned)(ib & 255) << 8) | ((unsigned)(ic & 255) << 16) | ((unsigned)id << 24);
}
__device__ __forceinline__ void win8_item(const float* __restrict__ W, unsigned char* W8, float* SB, int item, int lane) {
    const int n0 = 8 * item, c = lane & 3, r = lane >> 2;
    f32x2_t w[64];
#pragma unroll
    for (int i = 0; i < 64; ++i) w[i] = *(const GAS f32x2_t*)(W + (size_t)(64 * r + i) * INW + n0 + 2 * c);
    float m0 = 0.f, m1 = 0.f;
#pragma unroll
    for (int i = 0; i < 64; ++i) { m0 = fmaxf(m0, fabsf(w[i].x)); m1 = fmaxf(m1, fabsf(w[i].y)); }
#pragma unroll
    for (int o = 4; o < 64; o <<= 1) { m0 = fmaxf(m0, __shfl_xor(m0, o)); m1 = fmaxf(m1, __shfl_xor(m1, o)); }
    const float i0 = m0 > 0.f ? 127.f / m0 : 0.f, i1 = m1 > 0.f ? 127.f / m1 : 0.f;
    const RmIn rm;
    const int row0 = rm(n0 + 2 * c), row1 = rm(n0 + 2 * c + 1);
    GAS v4u* d0 = (GAS v4u*)(W8 + (size_t)row0 * D + 64 * r); GAS v4u* d1 = (GAS v4u*)(W8 + (size_t)row1 * D + 64 * r);
#pragma unroll
    for (int j = 0; j < 4; ++j) { v4u a, b;
#pragma unroll
        for (int q = 0; q < 4; ++q) { const int i = 16 * j + 4 * q;
            a[q] = pack_i8x4(w[i].x * i0, w[i + 1].x * i0, w[i + 2].x * i0, w[i + 3].x * i0);
            b[q] = pack_i8x4(w[i].y * i1, w[i + 1].y * i1, w[i + 2].y * i1, w[i + 3].y * i1); }
        d0[j] = a; d1[j] = b; }
    if (r == 0) { SB[row0] = m0 * (1.f / 127.f); SB[row1] = m1 * (1.f / 127.f); }
}
struct CvSrc { const float* W; const float* gain; bf16* WT; int ldw, K, k0, n0, kind, ebase; };
__device__ __forceinline__ CvSrc cv_src(const float* const* in, unsigned char* ws, int tau) { CvSrc c;
    const int t32 = tau & 31; int e;
    if (tau < 2048) { const int mi = tau >> 5; e = mi >> 1; c.kind = mi & 1; } else { e = (tau - 2048) >> 5; c.kind = 2; }
    if (c.kind < 2) { c.W = (c.kind == 0 ? in[27] : in[28]) + (size_t)e * D * 512; c.ldw = 512; c.K = D; c.k0 = (t32 >> 2) * 128; c.n0 = (t32 & 3) * 128; c.WT = (bf16*)(ws + WS_WGU); c.ebase = e * 1024 + c.kind * 128; c.gain = in[22]; }
    else { c.W = in[29] + (size_t)e * 512 * D; c.ldw = D; c.K = 512; c.k0 = (t32 >> 3) * 128; c.n0 = (t32 & 7) * 128; c.WT = (bf16*)(ws + WS_WD); c.ebase = e * 1024; c.gain = nullptr; }
    return c; }
#define CV_BAR() asm volatile("s_waitcnt lgkmcnt(0)\n\ts_barrier" ::: "memory")
#define CV_LOAD(W_, G_, tau_) do { const CvSrc c_ = cv_src(in, ws, (tau_)); \
        _Pragma("unroll") for (int i_ = 0; i_ < 8; ++i_) { const int row_ = 16 * wv + 2 * i_ + (lane >> 5); W_[i_] = __builtin_nontemporal_load((const GAS f32x4*)(c_.W + (size_t)(c_.k0 + row_) * c_.ldw + c_.n0 + 4 * (lane & 31))); G_[i_] = c_.gain ? c_.gain[c_.k0 + row_] : 1.f; } } while (0)
#define CV_STEP(W_, G_, tau_, nxt_) do { \
        _Pragma("unroll") for (int i_ = 0; i_ < 8; ++i_) { const int row_ = 16 * wv + 2 * i_ + (lane >> 5); *(LAS f32x4*)(tile + row_ * 132 + ((4 * (lane & 31)) ^ (((row_ >> 4) & 7) << 2))) = W_[i_] * G_[i_]; }     \
        CV_BAR(); \
        if ((nxt_) < first + ntiles) CV_LOAD(W_, G_, (nxt_));                   \
        { const CvSrc c = cv_src(in, ws, (tau_)); \
          const int ch = tid & 15;                                             \
          _Pragma("unroll") for (int q = 0; q < 4; ++q) { const int n = (tid >> 4) + 32 * q; const LAS float* sp = tile + (8 * ch) * 132 + (n ^ (((ch >> 1) & 7) << 2)); \
              v4u o; o.x = cvtpk_s(sp[0], sp[132]); o.y = cvtpk_s(sp[264], sp[396]); o.z = cvtpk_s(sp[528], sp[660]); o.w = cvtpk_s(sp[792], sp[924]); \
              const int nn = c.n0 + n; const int row = (c.kind < 2) ? c.ebase + (nn >> 7) * 256 + (nn & 127) : c.ebase + nn; \
              *(GAS v4u*)(c.WT + (size_t)row * c.K + c.k0 + 8 * ch) = o; } } \
        CV_BAR(); } while (0)
__device__ __forceinline__ void conv_tiles(const float* const* in, unsigned char* ws, LAS float* tile, int tid, int first, int ntiles) {
    const int lane = tid & 63, wv = tid >> 6;
    f32x4 wA[8], wB[8]; float gA[8], gB[8];
    if (ntiles > 0) CV_LOAD(wA, gA, first);
    if (ntiles > 1) CV_LOAD(wB, gB, first + 1);
#pragma unroll 1
    for (int j = 0; j < ntiles; j += 2) {
        CV_STEP(wA, gA, first + j, first + j + 2);
        if (j + 1 < ntiles) CV_STEP(wB, gB, first + j + 1, first + j + 3);
    }
}
#undef CV_LOAD
#undef CV_STEP
#undef CV_BAR
#define C8_BAR() asm volatile("s_waitcnt lgkmcnt(0)\n\ts_barrier" ::: "memory")
#define C8_LOAD(beta_) do { const int mi_ = (beta_) >> 4; const float* W_ = ((mi_ & 1) ? in[28] : in[27]) + (size_t)(mi_ >> 1) * D * 512 + 32 * ((beta_) & 15) + 4 * (tid & 7); \
        _Pragma("unroll") for (int p_ = 0; p_ < 16; ++p_) { const int k_ = 64 * p_ + (tid >> 3); w[p_] = __builtin_nontemporal_load((const GAS f32x4*)(W_ + (size_t)k_ * 512)); g[p_] = in[22][k_]; } } while (0)
__device__ __forceinline__ void conv8_tiles(const float* const* in, unsigned char* ws, LAS float* tile, LAS float* smax, int tid, int first, int ntiles) {
    f32x4 w[16]; float g[16];
    if (ntiles > 0) C8_LOAD(first);
#pragma unroll 1
    for (int j = 0; j < ntiles; ++j) { const int beta = first + j;
#pragma unroll
        for (int p = 0; p < 16; ++p) *(LAS f32x4*)(tile + (64 * p + (tid >> 3)) * 32 + 4 * (tid & 7)) = w[p] * g[p];
        C8_BAR();
        if (j + 1 < ntiles) C8_LOAD(beta + 1);
        const int n = tid & 31, seg = tid >> 5;
        float col[64]; float m = 0.f;
#pragma unroll
        for (int i = 0; i < 64; ++i) { col[i] = tile[(64 * seg + i) * 32 + n]; m = fmaxf(m, fabsf(col[i])); }
        smax[seg * 32 + n] = m;
        C8_BAR();
        float cm = 0.f;
#pragma unroll
        for (int sg = 0; sg < 16; ++sg) cm = fmaxf(cm, smax[sg * 32 + n]);
        const float qi = cm > 0.f ? 127.f / cm : 0.f;
        const int mi = beta >> 4, nn = 32 * (beta & 15) + n, row = (mi >> 1) * 1024 + (nn >> 7) * 256 + (nn & 127) + (mi & 1) * 128;
        GAS v4u* dst = (GAS v4u*)(ws + WS_WGU + (size_t)row * D + 64 * seg);
#pragma unroll
        for (int jj = 0; jj < 4; ++jj) { v4u o;
#pragma unroll
            for (int q = 0; q < 4; ++q) { const int i = 16 * jj + 4 * q; o[q] = pack_i8x4(col[i] * qi, col[i + 1] * qi, col[i + 2] * qi, col[i + 3] * qi); }
            dst[jj] = o; }
        if (seg == 0) ((float*)(ws + WS_SBGU))[row] = cm * (1.f / 127.f);
        C8_BAR();
    }
}
#undef C8_LOAD
#undef C8_BAR
__device__ __forceinline__ void quant_rows(const bf16* __restrict__ H, unsigned char* Q, const float* __restrict__ ssq, float* RS, int lane, int first, int count) {
    v4u a[4][2], b[4][2];
#pragma unroll
    for (int j = 0; j < 4; ++j) { const GAS v4u* p = (const GAS v4u*)(H + (size_t)(first + j) * D) + 2 * lane; a[j][0] = p[0]; a[j][1] = p[1]; }
#pragma unroll 1
    for (int r0 = first; r0 < first + count; r0 += 4) {
        if (r0 + 4 < first + count) {
#pragma unroll
            for (int j = 0; j < 4; ++j) { const GAS v4u* p = (const GAS v4u*)(H + (size_t)(r0 + 4 + j) * D) + 2 * lane; b[j][0] = p[0]; b[j][1] = p[1]; } }
#pragma unroll
        for (int j = 0; j < 4; ++j) {
            float v[16]; float am = 0.f;
#pragma unroll
            for (int h = 0; h < 2; ++h)
#pragma unroll
                for (int q = 0; q < 4; ++q) { const unsigned x = a[j][h][q]; v[8 * h + 2 * q] = __builtin_bit_cast(float, x << 16); v[8 * h + 2 * q + 1] = __builtin_bit_cast(float, x & 0xffff0000u); }
#pragma unroll
            for (int i = 0; i < 16; ++i) am = fmaxf(am, fabsf(v[i]));
#pragma unroll
            for (int o = 1; o < 64; o <<= 1) am = fmaxf(am, __shfl_xor(am, o));
            const float qi = am > 0.f ? 127.f / am : 0.f;
            v4u o4;
#pragma unroll
            for (int q = 0; q < 4; ++q) o4[q] = pack_i8x4(v[4 * q] * qi, v[4 * q + 1] * qi, v[4 * q + 2] * qi, v[4 * q + 3] * qi);
            *((GAS v4u*)(Q + (size_t)(r0 + j) * D) + lane) = o4;
            if (lane == 0) { const f32x4 q4 = *(const f32x4*)(ssq + (size_t)(r0 + j) * 4); RS[r0 + j] = rsqrtf(((q4[0] + q4[1]) + (q4[2] + q4[3])) * (1.f / D) + EPS) * am * (1.f / 127.f); }
        }
#pragma unroll
        for (int j = 0; j < 4; ++j) { a[j][0] = b[j][0]; a[j][1] = b[j][1]; }
    }
}
__device__ __forceinline__ void refresh(Frame& F) { int t = threadIdx.x; asm volatile("" : "+v"(t)); F.tid = t; F.lane = t & 63; F.wave = __builtin_amdgcn_readfirstlane(t >> 6); }
__device__ __forceinline__ void p0_prologue(Frame& F0, const float* const* in, unsigned char* ws) {
    Frame F = F0; refresh(F);
    LAS float* scr = (LAS float*)(F.lds + RING_OFF + F.wave * 16384);
    const int gw = F.vcu * NWAVES + F.wave, NGW = F.G * NWAVES;
    if (F.vcu < 96 && F.wave < 4) win8_item(in[3], ws + WS_WIN, (float*)(ws + WS_SB), F.vcu * 4 + F.wave, F.lane);
    tr_run(in, ws, scr, F.lane, TR_I_IN + gw, NGW, TR_NONEXPERT);
    __syncthreads();
    LAS float* wgr = (LAS float*)(F.lds + RING_OFF);
    for (int i = F.tid; i < 16384; i += NWAVES * 64) { const int k = i >> 4, r = i & 15; wgr[r * 1024 + k] = in[3][(size_t)k * INW + 3072 + r]; }
    __syncthreads();
    const float* x = in[0]; const float* g = in[2]; unsigned char* U8 = ws + WS_RA; float* SA = (float*)(ws + WS_SA); float* GR = (float*)(ws + WS_GR);
    f32x4 vnx[4];
    if (gw < T) {
#pragma unroll
        for (int j = 0; j < 4; ++j) vnx[j] = ((const GAS f32x4*)(x + (size_t)gw * D) + F.lane)[64 * j]; }
    for (int m = gw; m < T; m += NGW) {
        f32x4 v[4]; float s = 0.f;
#pragma unroll
        for (int j = 0; j < 4; ++j) v[j] = vnx[j];
        if (m + NGW < T) {
#pragma unroll
            for (int j = 0; j < 4; ++j) vnx[j] = ((const GAS f32x4*)(x + (size_t)(m + NGW) * D) + F.lane)[64 * j]; }
#pragma unroll
        for (int j = 0; j < 4; ++j) s += (v[j].x * v[j].x + v[j].y * v[j].y) + (v[j].z * v[j].z + v[j].w * v[j].w);
        const float rstd = rsqrtf(wave_sum(s) * (1.f / D) + EPS);
        GAS unsigned* o4 = (GAS unsigned*)(U8 + (size_t)m * D) + F.lane;
        float p[16];
#pragma unroll
        for (int r = 0; r < 16; ++r) p[r] = 0.f;
        float am = 0.f;
#pragma unroll
        for (int j = 0; j < 4; ++j) { const f32x4 gg = ((const GAS f32x4*)g)[F.lane + 64 * j]; v[j] = v[j] * rstd * gg;
            am = fmaxf(fmaxf(am, fmaxf(fabsf(v[j].x), fabsf(v[j].y))), fmaxf(fabsf(v[j].z), fabsf(v[j].w))); }
#pragma unroll
        for (int o = 1; o < 64; o <<= 1) am = fmaxf(am, __shfl_xor(am, o));
        const float qi = am > 0.f ? 127.f / am : 0.f;
        if (F.lane == 0) SA[m] = am * (1.f / 127.f);
#pragma unroll
        for (int j = 0; j < 4; ++j) {
            o4[64 * j] = pack_i8x4(v[j].x * qi, v[j].y * qi, v[j].z * qi, v[j].w * qi);
#pragma unroll
            for (int r = 0; r < 16; ++r) { const f32x4 w = *(const LAS f32x4*)(wgr + r * 1024 + 4 * (F.lane + 64 * j)); p[r] += (v[j].x * w.x + v[j].y * w.y) + (v[j].z * w.z + v[j].w * w.w);
                if ((r & 3) == 3) __builtin_amdgcn_sched_barrier(0); } }
        { const bool b5 = (F.lane & 32) != 0, b4 = (F.lane & 16) != 0, b3 = (F.lane & 8) != 0, b2 = (F.lane & 4) != 0;
#pragma unroll
          for (int i = 0; i < 8; ++i) { const float send = b5 ? p[i] : p[i + 8], keep = b5 ? p[i + 8] : p[i]; p[i] = keep + __shfl_xor(send, 32); }
#pragma unroll
          for (int i = 0; i < 4; ++i) { const float send = b4 ? p[i] : p[i + 4], keep = b4 ? p[i + 4] : p[i]; p[i] = keep + __shfl_xor(send, 16); }
#pragma unroll
          for (int i = 0; i < 2; ++i) { const float send = b3 ? p[i] : p[i + 2], keep = b3 ? p[i + 2] : p[i]; p[i] = keep + __shfl_xor(send, 8); }
          { const float send = b2 ? p[0] : p[1], keep = b2 ? p[1] : p[0]; p[0] = keep + __shfl_xor(send, 4); }
          p[0] += __shfl_xor(p[0], 2); p[0] += __shfl_xor(p[0], 1);
          if ((F.lane & 3) == 0) GR[(size_t)m * 16 + ((F.lane >> 2) & 15)] = p[0]; }
    }
    { bf16* WR = (bf16*)(ws + WS_WR); const float* gf = in[22]; const float* wgp = in[23]; const float* wep = in[25];
      for (int i = gw * 64 + F.lane; i < 256 * 1024; i += NGW * 64) { const int r = i >> 10, k = i & 1023, c = r & 127; unsigned short o = 0;
          if (c < 36) { const float w = gf[k] * (c < 32 ? wep[k * 32 + c] : wgp[k * 4 + (c - 32)]); const unsigned hi_ = f2bf(w); o = (unsigned short)((r < 128) ? hi_ : f2bf(w - bf2f((unsigned short)hi_))); }
          WR[i] = o; } }
    { GAS v4u* L4 = (GAS v4u*)(ws + WS_LIST); for (int i = gw * 64 + F.lane; i < 64 * CAP / 4; i += NGW * 64) L4[i] = (v4u){0u, 0u, 0u, 0u}; }
    const float* mem = in[1]; const float* gm = in[16]; bf16* MN = (bf16*)(ws + WS_MN);
    for (int m = gw; m < TM; m += NGW) {
        const GAS f32x4* xr = (const GAS f32x4*)(mem + (size_t)m * D) + F.lane;
        f32x4 v[4]; float s = 0.f;
#pragma unroll
        for (int j = 0; j < 4; ++j) { v[j] = xr[64 * j]; s += (v[j].x * v[j].x + v[j].y * v[j].y) + (v[j].z * v[j].z + v[j].w * v[j].w); }
        const float rstd = rsqrtf(wave_sum(s) * (1.f / D) + EPS);
        GAS unsigned long long* o8 = (GAS unsigned long long*)(MN + (size_t)m * D) + F.lane;
#pragma unroll
        for (int j = 0; j < 4; ++j) { const f32x4 gg = ((const GAS f32x4*)gm)[F.lane + 64 * j]; v[j] = v[j] * rstd * gg;
            o8[64 * j] = (unsigned long long)pk2(v[j].x, v[j].y) | ((unsigned long long)pk2(v[j].z, v[j].w) << 32); }
    }
}

struct OrderMN {
    struct Unit { int pm, pn; };
    const char* A; const char* B; int lda, ldb; int nM, nN, nwg, G, c; int i0 = 0, i1 = 1 << 30;
    __device__ __forceinline__ void init(const void* A_, int lda_, const void* B_, int ldb_, int M, int N, int G_, int c_) { A = (const char*)A_; B = (const char*)B_; lda = lda_; ldb = ldb_; nM = M / 256; nN = N / 256; nwg = nM * nN; G = G_; c = c_; }
    __device__ __forceinline__ bool next(int i, Unit& u) const {
        const int ii = i + i0; if (ii >= i1) return false;
        const long L = (long)ii * G + c; if (L >= nwg || c < 0) return false;
        int wgid = (int)L; { const int q = nwg / 8, r = nwg % 8, xcd = wgid % 8, off = wgid / 8; wgid = (xcd < r ? xcd * (q + 1) : r * (q + 1) + (xcd - r) * q) + off; }
        const int nig = 8 * nN, gid = wgid / nig, fm = gid * 8, gsz = (nM - fm) < 8 ? (nM - fm) : 8;
        u.pm = fm + ((wgid % nig) % gsz); u.pn = (wgid % nig) / gsz; return true;
    }
    __device__ __forceinline__ const char* pa(const Unit& u) const { return A + (size_t)u.pm * 256 * lda; }
    __device__ __forceinline__ const char* pb(const Unit& u) const { return B + (size_t)u.pn * 256 * ldb; }
};
__device__ __forceinline__ void st8(bf16* p, const f32x4& a, const f32x4& b) { v4u w; w.x = cvtpk_s(a[0], a[1]); w.y = cvtpk_s(a[2], a[3]); w.z = cvtpk_s(b[0], b[1]); w.w = cvtpk_s(b[2], b[3]); *(v4u*)p = w; }
__device__ __forceinline__ void st8x(bf16* p_new, const f32x4& a, const f32x4& b, int pull4) {
    v4u w; w.x = cvtpk_s(a[0], a[1]); w.y = cvtpk_s(a[2], a[3]); w.z = cvtpk_s(b[0], b[1]); w.w = cvtpk_s(b[2], b[3]);
    v4u o; o.x = (unsigned)__builtin_amdgcn_ds_bpermute(pull4, (int)w.x); o.y = (unsigned)__builtin_amdgcn_ds_bpermute(pull4, (int)w.y); o.z = (unsigned)__builtin_amdgcn_ds_bpermute(pull4, (int)w.z); o.w = (unsigned)__builtin_amdgcn_ds_bpermute(pull4, (int)w.w);
    *(v4u*)p_new = o; }
#define ST8X_ROLE() const int ln_ = fr + 16 * fq, fr2 = ln_ >> 2, fq2 = ln_ & 3, pull4 = 4 * (fr2 + 16 * fq2)
__device__ __forceinline__ float silu_f(float v) { return v * __builtin_amdgcn_rcpf(1.f + __builtin_amdgcn_exp2f(-LOG2E * v)); }

struct EpiIn {
    static constexpr bool PERM = true;
    bf16 *DQ, *DK, *DV, *GQ, *GK, *GV, *GG; const float *qn, *kn; const float *SA, *SB;
#define EI_X(ai, bj, m, n) (__builtin_convertvector(__builtin_bit_cast(i32x4, acc[ai][bj][m][n]), f32x4) * (sbv[bj][n] * sar))
    __device__ __forceinline__ void operator()(const f32x4 (&acc)[2][2][4][2], const OrderMN::Unit& u, int wr, int wc, int fr, int fq) const {
        const int tile = u.pn; const size_t row0 = (size_t)u.pm * 256 + wr * 64 + fr;
        ST8X_ROLE(); const size_t row0b = (size_t)u.pm * 256 + wr * 64 + fr2;
        f32x4 sbv[2][2];
#pragma unroll
        for (int bj = 0; bj < 2; ++bj)
#pragma unroll
            for (int n = 0; n < 2; ++n) sbv[bj][n] = *(const f32x4*)(SB + tile * 256 + 128 * bj + 32 * wc + 8 * fq + 4 * n);
        float sa8[8];
#pragma unroll
        for (int it = 0; it < 8; ++it) sa8[it] = SA[row0 + (it >> 2) * 128 + (it & 3) * 16];
        if (tile < 4) {
            const float* g = tile < 2 ? qn : kn; const float sc = tile < 2 ? QSCALE : 1.f;
            const bool img = tile >= 2;
            bf16* dst = (tile < 2 ? DQ : DK) + (tile & 1) * 256 + 64 * wc + 8 * fq;
            f32x4 gv[2][2];
#pragma unroll
            for (int bj = 0; bj < 2; ++bj)
#pragma unroll
                for (int n = 0; n < 2; ++n) gv[bj][n] = *(const f32x4*)(g + 32 * bj + 8 * fq + 4 * n) * sc;
#pragma unroll
            for (int ai = 0; ai < 2; ++ai)
#pragma unroll
                for (int m = 0; m < 4; ++m) {
                    const size_t tk = row0 + ai * 128 + m * 16;
                    const float sar = sa8[ai * 4 + m];
                    f32x4 xv[2][2];
                    float ss = 0.f;
#pragma unroll
                    for (int bj = 0; bj < 2; ++bj)
#pragma unroll
                        for (int n = 0; n < 2; ++n) { const f32x4 x = EI_X(ai, bj, m, n); xv[bj][n] = x; ss += (x[0] * x[0] + x[1] * x[1]) + (x[2] * x[2] + x[3] * x[3]); }
                    ss += __shfl_xor(ss, 16); ss += __shfl_xor(ss, 32);
                    const float r = rsqrtf(ss * (1.f / 64.f) + EPS);
                    bf16* rowp = dst + tk * 512; int cst = 32;
                    if (img) { const int hh = (tile & 1) * 2 + (wc >> 1), bb = (int)(tk >> 12), ss = (int)(tk & 4095);
                        rowp = DK + ((size_t)((bb * 4 + hh) * 64 + (ss >> 6))) * 8192 + (wc & 1) * 4096 + fq * 512 + (ss & 63) * 8; cst = 2048; }
                    if (img) {
#pragma unroll
                        for (int bj = 0; bj < 2; ++bj) st8(rowp + cst * bj, xv[bj][0] * r * gv[bj][0], xv[bj][1] * r * gv[bj][1]);
                    } else { bf16* rowq = DQ + (tile & 1) * 256 + 64 * wc + 8 * fq2 + (row0b + ai * 128 + m * 16) * 512;
#pragma unroll
                        for (int bj = 0; bj < 2; ++bj) st8x(rowq + 32 * bj, xv[bj][0] * r * gv[bj][0], xv[bj][1] * r * gv[bj][1], pull4); }
                }
        } else {
            bf16* dst; int ld; float sc = 1.f; bool act = false;
            if (tile < 6) { dst = DV + (tile - 4) * 256; ld = 512; }
            else if (tile == 6) { dst = GQ; ld = 256; sc = 0.125f; }
            else if (tile == 7) { dst = GK; ld = 256; }
            else if (tile < 10) { dst = GV + (tile - 8) * 256; ld = 512; }
            else { dst = GG + (tile - 10) * 256; ld = 512; act = true; }
            dst += wc * 32 + 8 * fq2;
            const bool vimg = tile < 6;
#pragma unroll
            for (int ai = 0; ai < 2; ++ai)
#pragma unroll
                for (int m = 0; m < 4; ++m) { const size_t tk = row0 + ai * 128 + m * 16, tk2 = row0b + ai * 128 + m * 16; bf16* rowp = dst + tk2 * ld; int cst = 128; const float sar = sa8[ai * 4 + m] * sc;
                    if (vimg) { const int bb = (int)(tk2 >> 12), ss = (int)(tk2 & 4095), rr = ss & 63;
                        rowp = DV + ((size_t)((bb * 4 + (tile - 4) * 2) * 64 + (ss >> 6))) * 8192 + (wc * 4 + (rr >> 4)) * 512 + (rr & 15) * 32 + 8 * fq2; cst = 64 * 8192; }
#pragma unroll
                    for (int bj = 0; bj < 2; ++bj) { f32x4 v0 = EI_X(ai, bj, m, 0), v1 = EI_X(ai, bj, m, 1);
                        if (act) {
#pragma unroll
                            for (int i = 0; i < 4; ++i) { v0[i] = silu_f(v0[i]); v1[i] = silu_f(v1[i]); } }
                        st8x(rowp + (size_t)cst * bj, v0, v1, pull4); } }
        }
    }
};
#undef EI_X
struct EpiNorm256 {
    static constexpr bool PERM = true;
    bf16* O; int ldo; const float* gain; const float* ssq; float post; LAS float* xch;
    template <class UnitT> __device__ __forceinline__ void operator()(const f32x4 (&acc)[2][2][4][2], const UnitT& u, int wr, int wc, int fr, int fq) const {
        const size_t row0 = (size_t)u.pm * 256 + wr * 64 + fr;
        float rs[2][4];
#pragma unroll
        for (int ai = 0; ai < 2; ++ai)
#pragma unroll
            for (int m = 0; m < 4; ++m) {
                float r = 1.f;
                if (ssq) { const f32x4 q = *(const f32x4*)(ssq + (row0 + ai * 128 + m * 16) * 4); r = rsqrtf(((q[0] + q[1]) + (q[2] + q[3])) * (1.f / D) + EPS); }
                rs[ai][m] = r;
                float ss = 0.f;
#pragma unroll
                for (int bj = 0; bj < 2; ++bj)
#pragma unroll
                    for (int n = 0; n < 2; ++n) { const f32x4 x = acc[ai][bj][m][n] * r; ss += (x[0] * x[0] + x[1] * x[1]) + (x[2] * x[2] + x[3] * x[3]); }
                ss += __shfl_xor(ss, 16); ss += __shfl_xor(ss, 32);
                if (fq == 0) xch[(ai * 128 + wr * 64 + m * 16 + fr) * 4 + wc] = ss;
            }
        asm volatile("s_waitcnt lgkmcnt(0)" ::: "memory"); __builtin_amdgcn_s_barrier(); asm volatile("" ::: "memory");
        f32x4 gv[2][2];
#pragma unroll
        for (int bj = 0; bj < 2; ++bj)
#pragma unroll
            for (int n = 0; n < 2; ++n) gv[bj][n] = *(const f32x4*)(gain + 128 * bj + 32 * wc + 8 * fq + 4 * n) * post;
        ST8X_ROLE();
        bf16* dst = O + (size_t)u.pn * 256 + wc * 32 + 8 * fq2;
#pragma unroll
        for (int ai = 0; ai < 2; ++ai)
#pragma unroll
            for (int m = 0; m < 4; ++m) {
                const f32x4 q = *(const LAS f32x4*)(xch + (ai * 128 + wr * 64 + m * 16 + fr) * 4);
                const float r = rs[ai][m] * rsqrtf(((q[0] + q[1]) + (q[2] + q[3])) * (1.f / 256.f) + EPS);
                bf16* rowp = dst + ((size_t)u.pm * 256 + wr * 64 + fr2 + ai * 128 + m * 16) * ldo;
#pragma unroll
                for (int bj = 0; bj < 2; ++bj) st8x(rowp + 128 * bj, acc[ai][bj][m][0] * r * gv[bj][0], acc[ai][bj][m][1] * r * gv[bj][1], pull4);
            }
    }
};
struct EpiPlain {
    static constexpr bool PERM = true;
    bf16* O; int ldo;
    __device__ __forceinline__ void operator()(const f32x4 (&acc)[2][2][4][2], const OrderMN::Unit& u, int wr, int wc, int fr, int fq) const {
        ST8X_ROLE();
        bf16* dst = O + ((size_t)u.pm * 256 + wr * 64 + fr2) * ldo + (size_t)u.pn * 256 + wc * 32 + 8 * fq2;
#pragma unroll
        for (int ai = 0; ai < 2; ++ai)
#pragma unroll
            for (int m = 0; m < 4; ++m)
#pragma unroll
                for (int bj = 0; bj < 2; ++bj) st8x(dst + (size_t)(ai * 128 + m * 16) * ldo + 128 * bj, acc[ai][bj][m][0], acc[ai][bj][m][1], pull4);
    }
};

template <bool BASE_BF16, bool SSQ>
struct EpiRes {
    static constexpr bool PERM = true;
    const void* base; bf16* OB; float* ssq; LAS float* xch;
    struct BaseRegs { f32x4 f[2][2]; v4u h[2]; };
    __device__ __forceinline__ void ld(BaseRegs& r, size_t off) const {
        if constexpr (BASE_BF16) { r.h[0] = *(const v4u*)((const bf16*)base + off); r.h[1] = *(const v4u*)((const bf16*)base + off + 128); }
        else { r.f[0][0] = *(const f32x4*)((const float*)base + off); r.f[0][1] = *(const f32x4*)((const float*)base + off + 4); r.f[1][0] = *(const f32x4*)((const float*)base + off + 128); r.f[1][1] = *(const f32x4*)((const float*)base + off + 132); } }
    __device__ __forceinline__ void get(const BaseRegs& r, int bj, f32x4& b0, f32x4& b1) const {
        if constexpr (BASE_BF16) { const v4u w = r.h[bj];
            b0 = (f32x4){__builtin_bit_cast(float, w.x << 16), __builtin_bit_cast(float, w.x & 0xffff0000u), __builtin_bit_cast(float, w.y << 16), __builtin_bit_cast(float, w.y & 0xffff0000u)};
            b1 = (f32x4){__builtin_bit_cast(float, w.z << 16), __builtin_bit_cast(float, w.z & 0xffff0000u), __builtin_bit_cast(float, w.w << 16), __builtin_bit_cast(float, w.w & 0xffff0000u)}; }
        else { b0 = r.f[bj][0]; b1 = r.f[bj][1]; } }
    __device__ __forceinline__ void operator()(const f32x4 (&acc)[2][2][4][2], const OrderMN::Unit& u, int wr, int wc, int fr, int fq) const {
        ST8X_ROLE(); const size_t offb = ((size_t)u.pm * 256 + wr * 64 + fr2) * 1024 + u.pn * 256 + wc * 32 + 8 * fq2;
        BaseRegs br[4];
        ld(br[0], offb); ld(br[1], offb + (size_t)16 * 1024); ld(br[2], offb + (size_t)32 * 1024); ld(br[3], offb + (size_t)48 * 1024);
#pragma unroll
        for (int it = 0; it < 8; ++it) { const int ai = it >> 2, m = it & 3; const size_t off = offb + (size_t)(ai * 128 + m * 16) * 1024; float ss = 0.f;
            v4u wa[2];
#pragma unroll
            for (int bj = 0; bj < 2; ++bj) { const f32x4 a0 = acc[ai][bj][m][0], a1 = acc[ai][bj][m][1];
                wa[bj].x = (unsigned)__builtin_amdgcn_ds_bpermute(pull4, (int)cvtpk_s(a0[0], a0[1])); wa[bj].y = (unsigned)__builtin_amdgcn_ds_bpermute(pull4, (int)cvtpk_s(a0[2], a0[3]));
                wa[bj].z = (unsigned)__builtin_amdgcn_ds_bpermute(pull4, (int)cvtpk_s(a1[0], a1[1])); wa[bj].w = (unsigned)__builtin_amdgcn_ds_bpermute(pull4, (int)cvtpk_s(a1[2], a1[3])); }
            f32x4 b00, b01, b10, b11; get(br[it & 3], 0, b00, b01); get(br[it & 3], 1, b10, b11);
            if (it + 4 < 8) ld(br[it & 3], offb + (size_t)(128 + (it & 3) * 16) * 1024);
#pragma unroll
            for (int bj = 0; bj < 2; ++bj) { const v4u w = wa[bj];
                const f32x4 c0 = (f32x4){__builtin_bit_cast(float, w.x << 16), __builtin_bit_cast(float, w.x & 0xffff0000u), __builtin_bit_cast(float, w.y << 16), __builtin_bit_cast(float, w.y & 0xffff0000u)};
                const f32x4 c1 = (f32x4){__builtin_bit_cast(float, w.z << 16), __builtin_bit_cast(float, w.z & 0xffff0000u), __builtin_bit_cast(float, w.w << 16), __builtin_bit_cast(float, w.w & 0xffff0000u)};
                const f32x4 h0 = (bj ? b10 : b00) + c0, h1 = (bj ? b11 : b01) + c1;
                st8(OB + off + 128 * bj, h0, h1);
                if constexpr (SSQ) ss += ((h0[0] * h0[0] + h0[1] * h0[1]) + (h0[2] * h0[2] + h0[3] * h0[3])) + ((h1[0] * h1[0] + h1[1] * h1[1]) + (h1[2] * h1[2] + h1[3] * h1[3])); }
            if constexpr (SSQ) { ss += __shfl_xor(ss, 1); ss += __shfl_xor(ss, 2);
                if (fq2 == 0) xch[(ai * 128 + wr * 64 + m * 16 + fr2) * 4 + wc] = ss; } }
        if constexpr (SSQ) {
        asm volatile("s_waitcnt lgkmcnt(0)" ::: "memory"); __builtin_amdgcn_s_barrier(); asm volatile("" ::: "memory");
        const size_t row0 = (size_t)u.pm * 256 + wr * 64 + fr;
        if (wc == 0 && fq == 0) {
#pragma unroll
            for (int ai = 0; ai < 2; ++ai)
#pragma unroll
                for (int m = 0; m < 4; ++m) { const f32x4 q = *(const LAS f32x4*)(xch + (ai * 128 + wr * 64 + m * 16 + fr) * 4); ssq[(row0 + ai * 128 + m * 16) * 4 + u.pn] = (q[0] + q[1]) + (q[2] + q[3]); } } }
    }
};
struct OrderPanel {
    struct Unit { int pm, pn; };
    const char* A; const char* B; int G, c;
    __device__ __forceinline__ bool next(int i, Unit& u) const { const int L = i * G + c; if (L >= 512) return false; u.pm = L >> 2; u.pn = L & 3; return true; }
    __device__ __forceinline__ const char* pa(const Unit& u) const { return A + (size_t)u.pm * 256 * 2048; }
    __device__ __forceinline__ const char* pb(const Unit& u) const { return B + (size_t)u.pn * 256 * 2048; }
};
struct OrderCross {
    struct Unit { int pm, pn; };
    const char* A; const char* B; int ldb, bstride, hstrideB; int G, c;
    __device__ __forceinline__ bool next(int i, Unit& u) const { const int L = i * G + c; if (L >= 512) return false; u.pm = L >> 2; u.pn = L & 3; return true; }
    __device__ __forceinline__ const char* pa(const Unit& u) const { return A + (size_t)u.pm * 256 * 2048 + u.pn * 512; }
    __device__ __forceinline__ const char* pb(const Unit& u) const { return B + (size_t)(u.pm >> 4) * bstride + (size_t)u.pn * hstrideB; }
};
struct EpiSoftmax {
    static constexpr bool PERM = true;
    bf16* P; float* rsum; LAS float* xch;
    __device__ __forceinline__ void operator()(const f32x4 (&acc)[2][2][4][2], const OrderCross::Unit& u, int wr, int wc, int fr, int fq) const {
        const size_t row0 = (size_t)u.pm * 256 + wr * 64 + fr;
#pragma unroll
        for (int ai = 0; ai < 2; ++ai)
#pragma unroll
            for (int m = 0; m < 4; ++m) { float mx = -1e30f;
#pragma unroll
                for (int bj = 0; bj < 2; ++bj)
#pragma unroll
                    for (int n = 0; n < 2; ++n) { const f32x4 x = acc[ai][bj][m][n]; mx = fmaxf(mx, fmaxf(fmaxf(x[0], x[1]), fmaxf(x[2], x[3]))); }
                mx = fmaxf(mx, __shfl_xor(mx, 16)); mx = fmaxf(mx, __shfl_xor(mx, 32));
                if (fq == 0) xch[(ai * 128 + wr * 64 + m * 16 + fr) * 4 + wc] = mx; }
        asm volatile("s_waitcnt lgkmcnt(0)" ::: "memory"); __builtin_amdgcn_s_barrier(); asm volatile("" ::: "memory");
        ST8X_ROLE();
        bf16* dst = P + ((size_t)u.pm * 256 + wr * 64 + fr2) * 1024 + (size_t)u.pn * 256 + wc * 32 + 8 * fq2;
#pragma unroll
        for (int ai = 0; ai < 2; ++ai)
#pragma unroll
            for (int m = 0; m < 4; ++m) { const f32x4 q = *(const LAS f32x4*)(xch + (ai * 128 + wr * 64 + m * 16 + fr) * 4); const float mx = fmaxf(fmaxf(q[0], q[1]), fmaxf(q[2], q[3]));
                const size_t row = row0 + ai * 128 + m * 16; float ss = 0.f;
#pragma unroll
                for (int bj = 0; bj < 2; ++bj) { f32x4 e0, e1;
#pragma unroll
                    for (int i = 0; i < 4; ++i) { e0[i] = __builtin_amdgcn_exp2f(acc[ai][bj][m][0][i] - mx); e1[i] = __builtin_amdgcn_exp2f(acc[ai][bj][m][1][i] - mx); }
                    v4u w; w.x = cvtpk_s(e0[0], e0[1]); w.y = cvtpk_s(e0[2], e0[3]); w.z = cvtpk_s(e1[0], e1[1]); w.w = cvtpk_s(e1[2], e1[3]);
                    { v4u o_; o_.x = (unsigned)__builtin_amdgcn_ds_bpermute(pull4, (int)w.x); o_.y = (unsigned)__builtin_amdgcn_ds_bpermute(pull4, (int)w.y); o_.z = (unsigned)__builtin_amdgcn_ds_bpermute(pull4, (int)w.z); o_.w = (unsigned)__builtin_amdgcn_ds_bpermute(pull4, (int)w.w);
                      *(v4u*)(dst + (size_t)(ai * 128 + m * 16) * 1024 + 128 * bj) = o_; }
#pragma unroll
                    for (int i = 0; i < 4; ++i) { const unsigned ww = w[i]; ss += __builtin_bit_cast(float, ww << 16) + __builtin_bit_cast(float, ww & 0xffff0000u); } }
                ss += __shfl_xor(ss, 16); ss += __shfl_xor(ss, 32);
                if (fq == 0) rsum[(row * 4 + u.pn) * 4 + wc] = ss;
                asm volatile("" ::: "memory"); }
    }
};
struct EpiPV {
    static constexpr bool PERM = true;
    bf16* O; const float* rsum;
    __device__ __forceinline__ void operator()(const f32x4 (&acc)[2][2][4][2], const OrderCross::Unit& u, int wr, int wc, int fr, int fq) const {
        ST8X_ROLE();
        const size_t row0 = (size_t)u.pm * 256 + wr * 64 + fr; bf16* dst = O + ((size_t)u.pm * 256 + wr * 64 + fr2) * 1024 + (size_t)u.pn * 256 + wc * 32 + 8 * fq2;
#pragma unroll
        for (int ai = 0; ai < 2; ++ai) {
            float inv4[4];
#pragma unroll
            for (int it = 0; it < 4; ++it) { const size_t row = row0 + ai * 128 + it * 16; const f32x4 q = *(const f32x4*)(rsum + (row * 4 + u.pn) * 4); inv4[it] = 1.f / ((q[0] + q[1]) + (q[2] + q[3])); }
#pragma unroll
            for (int m = 0; m < 4; ++m) { const size_t row = row0 + ai * 128 + m * 16; const float inv = inv4[m];
#pragma unroll
                for (int bj = 0; bj < 2; ++bj) st8x(dst + (size_t)(ai * 128 + m * 16) * 1024 + 128 * bj, acc[ai][bj][m][0] * inv, acc[ai][bj][m][1] * inv, pull4); }
            asm volatile("" ::: "memory"); }
    }
};

__device__ __forceinline__ void tred8(float (&p)[8], int lane) {
    const bool b3 = (lane & 8) != 0, b4 = (lane & 16) != 0, b5 = (lane & 32) != 0;
#pragma unroll
    for (int i = 0; i < 4; ++i) { const float send = b5 ? p[i] : p[i + 4], keep = b5 ? p[i + 4] : p[i]; p[i] = keep + __shfl_xor(send, 32); }
#pragma unroll
    for (int i = 0; i < 2; ++i) { const float send = b4 ? p[i] : p[i + 2], keep = b4 ? p[i + 2] : p[i]; p[i] = keep + __shfl_xor(send, 16); }
    { const float send = b3 ? p[0] : p[1], keep = b3 ? p[1] : p[0]; p[0] = keep + __shfl_xor(send, 8); }
    p[0] += __shfl_xor(p[0], 4); p[0] += __shfl_xor(p[0], 2); p[0] += __shfl_xor(p[0], 1);
}
__device__ __forceinline__ float fexp(float x) { return __builtin_amdgcn_exp2f(x * LOG2E); }
__device__ __forceinline__ float rdl_f(float v, int l) { return __builtin_bit_cast(float, __builtin_amdgcn_readlane(__builtin_bit_cast(int, v), l)); }
__device__ __forceinline__ void p7_router(Frame& F0, const float* const* in, const bf16* h2, unsigned char* ws) {
    Frame F = F0; refresh(F);
    const int gw = F.vcu * NWAVES + F.wave, NGW = F.G * NWAVES;
    LAS float* wet = (LAS float*)(F.lds + RING_OFF);
    const float* we = in[25];
    for (int i = F.tid; i < 32768; i += NWAVES * 64) { const int k = i >> 5, e = i & 31; wet[e * 1024 + k] = we[i]; }
    f32x4 wgv[4][4], gn[4];
#pragma unroll
    for (int j = 0; j < 4; ++j) { gn[j] = ((const GAS f32x4*)in[22])[F.lane + 64 * j];
#pragma unroll
        for (int i = 0; i < 4; ++i) wgv[j][i] = ((const GAS f32x4*)in[23])[4 * (F.lane + 64 * j) + i]; }
    const float bg0 = in[24][0], bg1 = in[24][1], bg2 = in[24][2], bg3 = in[24][3];
    unsigned* cnt = (unsigned*)(ws + WS_CTL) + CW_CNT; int* LIST = (int*)(ws + WS_LIST); float* GATE = (float*)(ws + WS_GATE); float* RSTD = (float*)(ws + WS_RSTD); int* TOKPOS = (int*)(ws + WS_TOKPOS);
    __syncthreads();
    v2u xw[4];
    if (gw < T) {
#pragma unroll
        for (int j = 0; j < 4; ++j) xw[j] = ((const GAS v2u*)(h2 + (size_t)gw * D) + F.lane)[64 * j]; }
    int pm_ = -1, pl0 = 0, pl1 = 0; unsigned pp0 = 0, pp1 = 0; float pgt0 = 0.f, pgt1 = 0.f, prs = 0.f;
    for (int m = gw; m < T; m += NGW) {
        f32x4 v[4]; float p[8];
#pragma unroll
        for (int i = 0; i < 8; ++i) p[i] = 0.f;
#pragma unroll
        for (int j = 0; j < 4; ++j) { const v2u w = xw[j]; v[j] = (f32x4){__builtin_bit_cast(float, w.x << 16), __builtin_bit_cast(float, w.x & 0xffff0000u), __builtin_bit_cast(float, w.y << 16), __builtin_bit_cast(float, w.y & 0xffff0000u)}; }
        if (m + NGW < T) {
#pragma unroll
            for (int j = 0; j < 4; ++j) xw[j] = ((const GAS v2u*)(h2 + (size_t)(m + NGW) * D) + F.lane)[64 * j]; }
#pragma unroll
        for (int j = 0; j < 4; ++j) {
            p[0] += (v[j].x * v[j].x + v[j].y * v[j].y) + (v[j].z * v[j].z + v[j].w * v[j].w);
            v[j] = v[j] * gn[j];
#pragma unroll
            for (int i = 0; i < 4; ++i) { const float xv = v[j][i]; p[1] += xv * wgv[j][i][0]; p[2] += xv * wgv[j][i][1]; p[3] += xv * wgv[j][i][2]; p[4] += xv * wgv[j][i][3]; } }
        tred8(p, F.lane);
        const float ssq = rdl_f(p[0], 0), rstd = rsqrtf(ssq * (1.f / D) + EPS);
        const float lg0 = rdl_f(p[0], 8) * rstd + bg0, lg1 = rdl_f(p[0], 16) * rstd + bg1, lg2 = rdl_f(p[0], 24) * rstd + bg2, lg3 = rdl_f(p[0], 32) * rstd + bg3;
        int gs = 0; float gm = lg0;
        if (lg1 > gm) { gm = lg1; gs = 1; } if (lg2 > gm) { gm = lg2; gs = 2; } if (lg3 > gm) { gm = lg3; gs = 3; }
        const float pg = __builtin_amdgcn_rcpf((fexp(lg0 - gm) + fexp(lg1 - gm)) + (fexp(lg2 - gm) + fexp(lg3 - gm)));
        gs = __builtin_amdgcn_readfirstlane(gs);
        float el[8];
#pragma unroll
        for (int c = 0; c < 8; ++c) { const LAS float* wc_ = wet + (gs * 8 + c) * 1024; float a = 0.f;
#pragma unroll
            for (int j = 0; j < 4; ++j) { const f32x4 w = *(const LAS f32x4*)(wc_ + 4 * (F.lane + 64 * j)); a += (v[j].x * w.x + v[j].y * w.y) + (v[j].z * w.z + v[j].w * w.w); }
            el[c] = a; }
        tred8(el, F.lane);
        { const float t = el[0];
#pragma unroll
          for (int c = 0; c < 8; ++c) el[c] = rdl_f(t, 8 * c) * rstd + in[26][gs * 8 + c]; }
        if (F.lane == 0) {
            float em = el[0];
#pragma unroll
            for (int c = 1; c < 8; ++c) em = fmaxf(em, el[c]);
            float ed = 0.f;
#pragma unroll
            for (int c = 0; c < 8; ++c) { el[c] = fexp(el[c] - em); ed += el[c]; }
            { const float ied = __builtin_amdgcn_rcpf(ed);
#pragma unroll
              for (int c = 0; c < 8; ++c) el[c] *= ied; }
            float v0 = el[0]; int i0 = 0;
#pragma unroll
            for (int c = 1; c < 8; ++c) if (el[c] > v0) { v0 = el[c]; i0 = c; }
            float v1 = -1.f; int i1 = 0;
#pragma unroll
            for (int c = 0; c < 8; ++c) if (c != i0 && el[c] > v1) { v1 = el[c]; i1 = c; }
            const float sum2 = v0 + v1;
            if (pm_ >= 0) { LIST[(size_t)pl0 * CAP + pp0] = pm_; GATE[(size_t)pl0 * CAP + pp0] = pgt0; LIST[(size_t)pl1 * CAP + pp1] = pm_; GATE[(size_t)pl1 * CAP + pp1] = pgt1;
                RSTD[pm_] = prs; TOKPOS[2 * pm_] = pl0 * CAP + (int)pp0; TOKPOS[2 * pm_ + 1] = pl1 * CAP + (int)pp1; }
            pl0 = gs * 8 + i0; pl1 = gs * 8 + i1;
            pp0 = atomicAdd(cnt + 64 * pl0, 1u); pp1 = atomicAdd(cnt + 64 * pl1, 1u);
            { const float is2 = pg * __builtin_amdgcn_rcpf(sum2); pgt0 = v0 * is2; pgt1 = v1 * is2; } prs = rstd; pm_ = m;
        }
    }
    if (F.lane == 0 && pm_ >= 0) { LIST[(size_t)pl0 * CAP + pp0] = pm_; GATE[(size_t)pl0 * CAP + pp0] = pgt0; LIST[(size_t)pl1 * CAP + pp1] = pm_; GATE[(size_t)pl1 * CAP + pp1] = pgt1;
        RSTD[pm_] = prs; TOKPOS[2 * pm_] = pl0 * CAP + (int)pp0; TOKPOS[2 * pm_ + 1] = pl1 * CAP + (int)pp1; }
}

struct EpiRouter {
    static constexpr bool PERM = false;
    const float* ssq; const float* bg; const float* be; unsigned* cnt; int* LIST; float* GATE; float* RSTD; int* TOKPOS; LAS float* xch;
    __device__ __forceinline__ void operator()(const f32x4 (&acc)[2][2][4][2], const OrderMN::Unit& u, int wr, int wc, int fr, int fq) const {
        const size_t row0 = (size_t)u.pm * 256 + wr * 64 + fr;
        if (wc == 1 && fq == 0) {
            const float b0 = bg[0], b1 = bg[1], b2 = bg[2], b3 = bg[3];
#pragma unroll
            for (int ai = 0; ai < 2; ++ai)
#pragma unroll
                for (int m = 0; m < 4; ++m) { const f32x4 q = *(const f32x4*)(ssq + (row0 + ai * 128 + m * 16) * 4);
                    const float rstd = rsqrtf(((q[0] + q[1]) + (q[2] + q[3])) * (1.f / D) + EPS);
                    const f32x4 lg = (acc[ai][0][m][0] + acc[ai][1][m][0]) * rstd + (f32x4){b0, b1, b2, b3};
                    int gs = 0; float gm = lg[0];
                    if (lg[1] > gm) { gm = lg[1]; gs = 1; } if (lg[2] > gm) { gm = lg[2]; gs = 2; } if (lg[3] > gm) { gm = lg[3]; gs = 3; }
                    const float pg = __builtin_amdgcn_rcpf((fexp(lg[0] - gm) + fexp(lg[1] - gm)) + (fexp(lg[2] - gm) + fexp(lg[3] - gm)));
                    *(LAS f32x4*)(xch + (ai * 128 + wr * 64 + m * 16 + fr) * 4) = (f32x4){__builtin_bit_cast(float, gs), pg, rstd, 0.f}; } }
        asm volatile("s_waitcnt lgkmcnt(0)" ::: "memory"); __builtin_amdgcn_s_barrier(); asm volatile("" ::: "memory");
        if (wc == 0) {
#pragma unroll
            for (int ai = 0; ai < 2; ++ai) {
            int l0a[4], l1a[4]; unsigned p0a[4], p1a[4]; float g0a[4], g1a[4], rsa[4]; bool own[4];
#pragma unroll
                for (int m = 0; m < 4; ++m) { const int it = m; const int rl = ai * 128 + wr * 64 + m * 16 + fr; const f32x4 gi = *(const LAS f32x4*)(xch + rl * 4);
                    const int gs = __builtin_bit_cast(int, gi[0]); const float pg = gi[1], rstd = gi[2];
                    const f32x4 a0 = acc[ai][0][m][0] + acc[ai][1][m][0], a1 = acc[ai][0][m][1] + acc[ai][1][m][1];
                    f32x4 mine;
#pragma unroll
                    for (int i = 0; i < 4; ++i) mine[i] = (gs >> 1) ? a1[i] : a0[i];
                    f32x4 other;
#pragma unroll
                    for (int i = 0; i < 4; ++i) other[i] = __shfl_xor(mine[i], 16);
                    own[it] = (fq == 2 * (gs & 1)); l0a[it] = 0; l1a[it] = 0; p0a[it] = 0u; p1a[it] = 0u; g0a[it] = 0.f; g1a[it] = 0.f; rsa[it] = rstd;
                    if (own[it]) {
                        float el[8];
#pragma unroll
                        for (int i = 0; i < 4; ++i) { el[i] = mine[i] * rstd + be[gs * 8 + i]; el[4 + i] = other[i] * rstd + be[gs * 8 + 4 + i]; }
                        float em = el[0];
#pragma unroll
                        for (int c = 1; c < 8; ++c) em = fmaxf(em, el[c]);
                        float ed = 0.f;
#pragma unroll
                        for (int c = 0; c < 8; ++c) { el[c] = fexp(el[c] - em); ed += el[c]; }
                        { const float ied = __builtin_amdgcn_rcpf(ed);
#pragma unroll
                          for (int c = 0; c < 8; ++c) el[c] *= ied; }
                        float v0 = el[0]; int i0 = 0;
#pragma unroll
                        for (int c = 1; c < 8; ++c) if (el[c] > v0) { v0 = el[c]; i0 = c; }
                        float v1 = -1.f; int i1 = 0;
#pragma unroll
                        for (int c = 0; c < 8; ++c) if (c != i0 && el[c] > v1) { v1 = el[c]; i1 = c; }
                        const float is2 = pg * __builtin_amdgcn_rcpf(v0 + v1);
                        l0a[it] = gs * 8 + i0; l1a[it] = gs * 8 + i1; g0a[it] = v0 * is2; g1a[it] = v1 * is2;
                        p0a[it] = atomicAdd(cnt + 64 * l0a[it], 1u); p1a[it] = atomicAdd(cnt + 64 * l1a[it], 1u);
                    } }
#pragma unroll
            for (int it = 0; it < 4; ++it) if (own[it]) { const int tok = (int)(u.pm * 256 + ai * 128 + wr * 64 + it * 16 + fr);
                LIST[(size_t)l0a[it] * CAP + p0a[it]] = tok; GATE[(size_t)l0a[it] * CAP + p0a[it]] = g0a[it];
                LIST[(size_t)l1a[it] * CAP + p1a[it]] = tok; GATE[(size_t)l1a[it] * CAP + p1a[it]] = g1a[it];
                TOKPOS[2 * tok] = l0a[it] * CAP + (int)p0a[it]; TOKPOS[2 * tok + 1] = l1a[it] * CAP + (int)p1a[it]; }
            asm volatile("" ::: "memory"); }
        }
    }
};

__device__ __forceinline__ void moe_table(Frame& F, const unsigned char* ws) {
    LAS int* tab = (LAS int*)(F.lds + TAB_OFF);
    int t_ = threadIdx.x; asm volatile("" : "+v"(t_));
    if (t_ < 64) {
        const unsigned* cnt = (const unsigned*)(ws + WS_CTL) + CW_CNT;
        const int c = (t_ < 32) ? (int)__hip_atomic_load(cnt + 64 * t_, RLX_AGENT) : 0;
        const int tiles = (c + 255) >> 8; int incl = tiles;
#pragma unroll
        for (int off = 1; off < 32; off <<= 1) { const int t = __shfl_up(incl, off); if (t_ >= off) incl += t; }
        if (t_ < 32) { tab[t_] = incl - tiles; tab[65 + t_] = c; }
        if (t_ == 31) tab[32] = incl;
    }
    __syncthreads();
}
struct OrderMoe {
    struct Unit { int l, rt, ct, grt; };
    const LAS int* tab; int l0, l1;
    const char* A; const char* B; size_t bstride  ; int lda, ldb; const int* LIST; int G, c; bool gather;
    __device__ __forceinline__ bool next(int i, Unit& u) const {
        const int L = i * G + c, t0 = __builtin_amdgcn_readfirstlane(tab[l0]), nun = (__builtin_amdgcn_readfirstlane(tab[l1]) - t0) * 4; if (L >= nun) return false;
        const int g = t0 + (L >> 2); int l = l0, hi_ = l1 - 1;
        while (l < hi_) { const int mid = (l + hi_ + 1) >> 1; if (__builtin_amdgcn_readfirstlane(tab[mid]) <= g) l = mid; else hi_ = mid - 1; }
        u.l = l; u.rt = g - __builtin_amdgcn_readfirstlane(tab[l]); u.ct = L & 3; u.grt = g; return true;
    }
    __device__ __forceinline__ const char* pa(const Unit& u) const { return gather ? A : A + (size_t)u.grt * 256 * lda; }
    __device__ __forceinline__ const char* pb(const Unit& u) const { return B + (size_t)(u.l & 31) * bstride + (size_t)u.ct * 256 * ldb; }
    __device__ __forceinline__ const int* idx(const Unit& u) const { return LIST + (size_t)u.l * CAP + u.rt * 256; }
};
struct EpiGU {
    static constexpr bool PERM = true;
    bf16* HID; const int* LIST; const float* RSTD; const float* SBGU;
#define EG_X(ai, bj, m, n) (__builtin_convertvector(__builtin_bit_cast(i32x4, acc[ai][bj][m][n]), f32x4) * (sbv[bj][n] * rs))
    __device__ __forceinline__ void operator()(const f32x4 (&acc)[2][2][4][2], const OrderMoe::Unit& u, int wr, int wc, int fr, int fq) const {
        const int* lp = LIST + (size_t)u.l * CAP + u.rt * 256 + wr * 64 + fr;
        f32x4 sbv[2][2];
#pragma unroll
        for (int bj = 0; bj < 2; ++bj)
#pragma unroll
            for (int n = 0; n < 2; ++n) sbv[bj][n] = *(const f32x4*)(SBGU + (size_t)(u.l & 31) * 1024 + u.ct * 256 + 128 * bj + 32 * wc + 8 * fq + 4 * n);
        ST8X_ROLE();
        bf16* dst = HID + ((size_t)u.grt * 256 + wr * 64 + fr2) * 512 + u.ct * 128 + wc * 32 + 8 * fq2;
        int tk8[8]; float rs8[8];
#pragma unroll
        for (int it = 0; it < 8; ++it) tk8[it] = lp[(it >> 2) * 128 + (it & 3) * 16];
#pragma unroll
        for (int it = 0; it < 8; ++it) rs8[it] = RSTD[tk8[it]];
#pragma unroll
        for (int ai = 0; ai < 2; ++ai) {
#pragma unroll
            for (int m = 0; m < 4; ++m) { const float rs = rs8[ai * 4 + m];
                f32x4 h0, h1; const f32x4 g0 = EG_X(ai, 0, m, 0), g1 = EG_X(ai, 0, m, 1), u0 = EG_X(ai, 1, m, 0), u1 = EG_X(ai, 1, m, 1);
#pragma unroll
                for (int i = 0; i < 4; ++i) { h0[i] = silu_f(g0[i]) * u0[i]; h1[i] = silu_f(g1[i]) * u1[i]; }
                st8x(dst + (size_t)(ai * 128 + m * 16) * 512, h0, h1, pull4); }
            asm volatile("" ::: "memory"); }
    }
};
#undef EG_X
struct EpiY {
    static constexpr bool PERM = true;
    bf16* Y; const float* GATE;
    __device__ __forceinline__ void operator()(const f32x4 (&acc)[2][2][4][2], const OrderMoe::Unit& u, int wr, int wc, int fr, int fq) const {
        const float* gp = GATE + (size_t)u.l * CAP + u.rt * 256 + wr * 64 + fr;
        ST8X_ROLE();
        bf16* dst = Y + ((size_t)u.grt * 256 + wr * 64 + fr2) * 1024 + u.ct * 256 + wc * 32 + 8 * fq2;
        float gv8[8];
#pragma unroll
        for (int it = 0; it < 8; ++it) gv8[it] = gp[(it >> 2) * 128 + (it & 3) * 16];
#pragma unroll
        for (int ai = 0; ai < 2; ++ai)
#pragma unroll
            for (int m = 0; m < 4; ++m) { const float g = gv8[ai * 4 + m];
#pragma unroll
                for (int bj = 0; bj < 2; ++bj) st8x(dst + (size_t)(ai * 128 + m * 16) * 1024 + 128 * bj, acc[ai][bj][m][0] * g, acc[ai][bj][m][1] * g, pull4);
                asm volatile("" ::: "memory"); }
    }
};
__device__ __forceinline__ void p10_combine(Frame& F0, const bf16* H2B, const bf16* Y, float* out, const unsigned char* ws) {
    Frame F = F0; refresh(F);
    const int gw = F.vcu * NWAVES + F.wave, NGW = F.G * NWAVES;
    const LAS int* tab = (const LAS int*)(F.lds + TAB_OFF); const int* TOKPOS = (const int*)(ws + WS_TOKPOS);
    for (int m = gw; m < T; m += NGW) {
        const int t0 = TOKPOS[2 * m], t1 = TOKPOS[2 * m + 1];
        const size_t r0 = (size_t)256 * tab[t0 >> 15] + (t0 & (CAP - 1)), r1 = (size_t)256 * tab[t1 >> 15] + (t1 & (CAP - 1));
        const GAS v4u* hp = (const GAS v4u*)(H2B + (size_t)m * D) + F.lane; const GAS v4u* y0 = (const GAS v4u*)(Y + r0 * D) + F.lane; const GAS v4u* y1 = (const GAS v4u*)(Y + r1 * D) + F.lane;
        GAS f32x4* op = (GAS f32x4*)(out + (size_t)m * D) + 2 * F.lane;
#pragma unroll
        for (int jj = 0; jj < 2; ++jj) { const v4u a = hp[64 * jj], b = y0[64 * jj], c = y1[64 * jj]; f32x4 o0, o1;
#pragma unroll
            for (int i = 0; i < 2; ++i) {
                o0[2 * i] = (__builtin_bit_cast(float, a[i] << 16) + __builtin_bit_cast(float, b[i] << 16)) + __builtin_bit_cast(float, c[i] << 16);
                o0[2 * i + 1] = (__builtin_bit_cast(float, a[i] & 0xffff0000u) + __builtin_bit_cast(float, b[i] & 0xffff0000u)) + __builtin_bit_cast(float, c[i] & 0xffff0000u);
                o1[2 * i] = (__builtin_bit_cast(float, a[2 + i] << 16) + __builtin_bit_cast(float, b[2 + i] << 16)) + __builtin_bit_cast(float, c[2 + i] << 16);
                o1[2 * i + 1] = (__builtin_bit_cast(float, a[2 + i] & 0xffff0000u) + __builtin_bit_cast(float, b[2 + i] & 0xffff0000u)) + __builtin_bit_cast(float, c[2 + i] & 0xffff0000u); }
            op[128 * jj] = o0; op[128 * jj + 1] = o1; }
    }
}

namespace da {
constexpr int STG = 32768, XOFF = 65536;
typedef short s16x4 __attribute__((ext_vector_type(4)));
typedef short v4i16_t __attribute__((ext_vector_type(4)));
__device__ __forceinline__ s16x4 vtr(const LAS unsigned char* p) { return __builtin_bit_cast(s16x4, __builtin_amdgcn_ds_read_tr16_b64_v4i16((LAS v4i16_t*)p)); }
__device__ __forceinline__ float hswap_max(float m) { auto rr = __builtin_amdgcn_permlane32_swap(__float_as_uint(m), __float_as_uint(m), false, false); return fmaxf(__uint_as_float(rr[0]), __uint_as_float(rr[1])); }
__device__ __forceinline__ float hswap_sum(float m) { auto rr = __builtin_amdgcn_permlane32_swap(__float_as_uint(m), __float_as_uint(m), false, false); return __uint_as_float(rr[0]) + __uint_as_float(rr[1]); }
#define DA_BAR() asm volatile("s_waitcnt vmcnt(0) lgkmcnt(0)\n\ts_barrier" ::: "memory")

__device__ __forceinline__ void unit(LAS unsigned char* lds, LAS float* wsf_all, int b, int h, int qb, const bf16* __restrict__ DQ, const bf16* __restrict__ DK, const bf16* __restrict__ DV, bf16* MIX, float lam, const float* __restrict__ on_gain) {
    int tid_ = threadIdx.x; asm volatile("" : "+v"(tid_));
    const int tid = tid_, lane = tid & 63, r32 = lane & 31, hi = lane >> 5; const int wid = __builtin_amdgcn_readfirstlane(tid >> 6);
    const int sm = wid >> 2, rb = wid & 3;
    const size_t rowbase = (size_t)b * SEQ;
    const int q0 = qb * 128 + rb * 32, cw = q0 >> 6, NT = 2 * qb + 2;
    LAS float* wsf = wsf_all + wid * 64;
    bf16x8 qr[4];
    { const bf16* Qw = DQ + (rowbase + q0 + r32) * 512 + h * 128 + sm * 64 + hi * 8;
#pragma unroll
      for (int d0 = 0; d0 < 4; ++d0) qr[d0] = *(const bf16x8*)(Qw + d0 * 16); }
    const bf16* k1src = DK + (rowbase + lane) * 512 + h * 128 + wid * 8;
    const bf16* v0src = DV + (rowbase + 16 * (wid & 3) + (lane >> 2)) * 512 + h * 128 + (wid >> 2) * 32 + (lane & 3) * 8;
#define DA_DMA(j, st) do { LAS unsigned char* sb_ = lds + (st) * STG; const size_t go_ = (size_t)(j) * 64 * 512; \
        __builtin_amdgcn_global_load_lds((const unsigned*)(k1src + go_), (LAS unsigned*)(sb_ + wid * 1024), 16, 0, 0); \
        __builtin_amdgcn_global_load_lds((const unsigned*)(k1src + go_ + 64), (LAS unsigned*)(sb_ + 8192 + wid * 1024), 16, 0, 0); \
        __builtin_amdgcn_global_load_lds((const unsigned*)(v0src + go_), (LAS unsigned*)(sb_ + 16384 + wid * 1024), 16, 0, 0); \
        __builtin_amdgcn_global_load_lds((const unsigned*)(v0src + go_ + 64), (LAS unsigned*)(sb_ + 16384 + (wid + 8) * 1024), 16, 0, 0); } while (0)
    float m = -1e30f, l = 0.f;
    f32x16 o[4];
#pragma unroll
    for (int i = 0; i < 4; ++i) o[i] = f32x16{};
    DA_DMA(0, 0);
    for (int j = 0; j < NT; ++j) {
        DA_BAR();
        if (j + 1 < NT) DA_DMA(j + 1, (j + 1) & 1);
        if (j <= cw) {
            const LAS unsigned char* sb = lds + (j & 1) * STG;
            const LAS unsigned char* kb = sb + sm * 8192 + hi * 1024 + r32 * 16;
            bf16x8 kf0[4], kf1[4];
#pragma unroll
            for (int d0 = 0; d0 < 4; ++d0) { kf0[d0] = *(const LAS bf16x8*)(kb + d0 * 2048); kf1[d0] = *(const LAS bf16x8*)(kb + d0 * 2048 + 512); }
            const LAS unsigned char* vp = sb + 16384 + ((lane >> 4) & 1) * 32 + (lane & 3) * 8 + (4 * hi + ((lane & 15) >> 2)) * 64;
            s16x4 vl[2][4], vh[2][4];
#pragma unroll
            for (int blk = 0; blk < 4; ++blk) { vl[0][blk] = vtr(vp + (blk * 4) * 1024); vh[0][blk] = vtr(vp + (blk * 4) * 1024 + 512); }
            f32x16 p0 = f32x16{}, p1 = f32x16{};
#pragma unroll
            for (int d0 = 0; d0 < 4; ++d0) {
                p0 = __builtin_amdgcn_mfma_f32_32x32x16_bf16(kf0[d0], qr[d0], p0, 0, 0, 0);
                p1 = __builtin_amdgcn_mfma_f32_32x32x16_bf16(kf1[d0], qr[d0], p1, 0, 0, 0);
            }
            float tm = fmaxf(p0[0], p1[0]);
#pragma unroll
            for (int r = 1; r < 16; ++r) tm = fmaxf(tm, fmaxf(p0[r], p1[r]));
            tm = hswap_max(tm);
            if (__any(tm > m + 8.f)) {
                const float mn = fmaxf(m, tm), alpha = __builtin_amdgcn_exp2f(m - mn); m = mn;
                l *= alpha;
                if (hi == 0) wsf[r32] = alpha;
                asm volatile("s_waitcnt lgkmcnt(0)" ::: "memory");
#pragma unroll
                for (int g = 0; g < 4; ++g) { const f32x4 a4 = *(const LAS f32x4*)(wsf + 8 * g + 4 * hi);
#pragma unroll
                    for (int blk = 0; blk < 4; ++blk)
#pragma unroll
                        for (int i = 0; i < 4; ++i) o[blk][4 * g + i] *= a4[i]; }
            }
            float rs = 0.f;
#pragma unroll
            for (int r = 0; r < 16; ++r) { p0[r] = __builtin_amdgcn_exp2f(p0[r] - m); p1[r] = __builtin_amdgcn_exp2f(p1[r] - m); rs += p0[r] + p1[r]; }
            l += rs;
            v4u pw[4];
#pragma unroll
            for (int i = 0; i < 4; ++i) { pw[0][i] = cvtpk_s(p0[2 * i], p0[2 * i + 1]); pw[1][i] = cvtpk_s(p0[8 + 2 * i], p0[9 + 2 * i]); pw[2][i] = cvtpk_s(p1[2 * i], p1[2 * i + 1]); pw[3][i] = cvtpk_s(p1[8 + 2 * i], p1[9 + 2 * i]); }
#pragma unroll
            for (int s = 0; s < 4; ++s) {
                if (s < 3) {
#pragma unroll
                    for (int blk = 0; blk < 4; ++blk) { vl[(s + 1) & 1][blk] = vtr(vp + (blk * 4 + s + 1) * 1024); vh[(s + 1) & 1][blk] = vtr(vp + (blk * 4 + s + 1) * 1024 + 512); } }
#pragma unroll
                for (int blk = 0; blk < 4; ++blk) { const s16x4 lo = vl[s & 1][blk], hh = vh[s & 1][blk];
                    o[blk] = __builtin_amdgcn_mfma_f32_32x32x16_bf16(__builtin_bit_cast(bf16x8, pw[s]), (bf16x8){lo[0], lo[1], lo[2], lo[3], hh[0], hh[1], hh[2], hh[3]}, o[blk], 0, 0, 0); }
            }
        }
    }
    l = hswap_sum(l);
    { const float inv = (sm ? lam : 1.f) / l;
      if (hi == 0) wsf[r32] = inv;
      asm volatile("s_waitcnt lgkmcnt(0)" ::: "memory");
#pragma unroll
      for (int g = 0; g < 4; ++g) { const f32x4 a4 = *(const LAS f32x4*)(wsf + 8 * g + 4 * hi);
#pragma unroll
          for (int blk = 0; blk < 4; ++blk)
#pragma unroll
              for (int i = 0; i < 4; ++i) o[blk][4 * g + i] *= a4[i]; } }
    LAS float* X = (LAS float*)(lds + XOFF) + rb * 4096;
    if (sm == 1) {
#pragma unroll
        for (int blk = 0; blk < 4; ++blk)
#pragma unroll
            for (int r = 0; r < 16; ++r) X[((r & 3) + 8 * (r >> 2) + 4 * hi) * 128 + blk * 32 + r32] = o[blk][r];
    }
    DA_BAR();
    if (sm == 0) {
#pragma unroll
        for (int blk = 0; blk < 4; ++blk)
#pragma unroll
            for (int r = 0; r < 16; ++r) { LAS float* xp = X + ((r & 3) + 8 * (r >> 2) + 4 * hi) * 128 + blk * 32 + r32; *xp = o[blk][r] - *xp; }
        asm volatile("s_waitcnt lgkmcnt(0)" ::: "memory");
        const int q = lane >> 1, half = lane & 1;
        const LAS f32x4* xr = (const LAS f32x4*)(X + q * 128 + half * 64);
        f32x4 v[16]; float ss = 0.f;
#pragma unroll
        for (int i = 0; i < 16; ++i) { v[i] = xr[i]; ss += (v[i][0] * v[i][0] + v[i][1] * v[i][1]) + (v[i][2] * v[i][2] + v[i][3] * v[i][3]); }
        ss += __shfl_xor(ss, 1);
        const float rstd = rsqrtf(ss * (1.f / 128.f) + EPS) * (1.f - LAM_INIT);
        bf16* op = MIX + (rowbase + q0 + q) * 1024 + h * 128 + half * 64;
#pragma unroll
        for (int i = 0; i < 8; ++i) { const f32x4 g0 = *(const f32x4*)(on_gain + half * 64 + 8 * i), g1 = *(const f32x4*)(on_gain + half * 64 + 8 * i + 4);
            st8(op + 8 * i, v[2 * i] * rstd * g0, v[2 * i + 1] * rstd * g1); }
    }
    DA_BAR();
#undef DA_DMA
}
}

namespace da2 {
using da::s16x4; using da::vtr; using da::hswap_max; using da::hswap_sum;
constexpr int SLK = 16384, SLV = 16384, L_K = 0, L_V = 65536, XOFF = 0;
#define D2_SBAR() __builtin_amdgcn_sched_barrier(0)
#define D2_PIN(x) asm volatile("" : "+v"(x))
#define D2_WAIT_BAR(N) asm volatile("s_waitcnt vmcnt(" #N ") lgkmcnt(0)\n\ts_barrier" ::: "memory")
#define D2_MFMA(a, b, c) __builtin_amdgcn_mfma_f32_32x32x16_bf16(a, b, c, 0, 0, 0)
#define D2_MX3(a, b, c) __builtin_fmaxf(__builtin_fmaxf((a), (b)), (c))
__device__ __forceinline__ float rowmax(const f32x16& p0, const f32x16& p1) {
    float a = D2_MX3(p0[0], p0[1], p1[0]), b = D2_MX3(p0[2], p0[3], p1[1]); a = D2_MX3(a, p1[2], p1[3]);
#pragma unroll
    for (int r = 4; r < 16; r += 4) { a = D2_MX3(a, p0[r], p0[r + 1]); b = D2_MX3(b, p0[r + 2], p0[r + 3]); a = D2_MX3(a, p1[r], p1[r + 1]); b = D2_MX3(b, p1[r + 2], p1[r + 3]); }
    return hswap_max(__builtin_fmaxf(a, b)); }

template <bool FAST>
__device__ __forceinline__ void unit(LAS unsigned char* lds, LAS float* wsf_all, int b, int h, int qb, const bf16* __restrict__ DQ, const bf16* __restrict__ DK, const bf16* __restrict__ DV, bf16* MIX, float lam, const float* __restrict__ on_gain,
                                     unsigned* qctr, volatile LAS unsigned* qslot) {
    int tid_ = threadIdx.x; asm volatile("" : "+v"(tid_));
    const int tid = tid_, lane = tid & 63, r32 = lane & 31, hi = lane >> 5; const int wid = __builtin_amdgcn_readfirstlane(tid >> 6);
    const int sm = wid >> 2, rb = wid & 3;
    const size_t rowbase = (size_t)b * SEQ;
    const int q0 = qb * 128 + rb * 32, NT = 2 * qb + 2; const bool full_last = rb >= 2;
    LAS float* wsf = wsf_all + wid * 64;
    bf16x8 qr[4];
    { const bf16* Qw = DQ + (rowbase + q0 + r32) * 512 + h * 128 + sm * 64 + hi * 8;
#pragma unroll
      for (int d0 = 0; d0 < 4; ++d0) qr[d0] = *(const bf16x8*)(Qw + d0 * 16); }
    const bf16* k1src = DK + ((size_t)((b * 4 + h) * 64)) * 8192 + wid * 512 + lane * 8;
    const bf16* v0src = DV + ((size_t)((b * 4 + h) * 64)) * 8192 + wid * 512 + lane * 8;
#define D2_DMA_K(t_, so_) do { const size_t go_ = (size_t)(t_) * 8192; LAS unsigned char* d_ = lds + L_K + (so_) + wid * 1024; \
        __builtin_amdgcn_global_load_lds((const unsigned*)(k1src + go_), (LAS unsigned*)d_, 16, 0, 0); \
        __builtin_amdgcn_global_load_lds((const unsigned*)(k1src + go_ + 4096), (LAS unsigned*)(d_ + 8192), 16, 0, 0); } while (0)
#define D2_DMA_V(t_, so_) do { const size_t go_ = (size_t)(t_) * 8192; LAS unsigned char* d_ = lds + L_V + (so_) + wid * 1024; \
        __builtin_amdgcn_global_load_lds((const unsigned*)(v0src + go_), (LAS unsigned*)d_, 16, 0, 0); \
        __builtin_amdgcn_global_load_lds((const unsigned*)(v0src + go_ + 4096), (LAS unsigned*)(d_ + 8192), 16, 0, 0); } while (0)
    const LAS unsigned char* kp0 = lds + L_K + sm * 8192 + hi * 1024 + r32 * 16;
    const LAS unsigned char* vp0 = lds + L_V + ((lane >> 4) & 1) * 32 + (lane & 3) * 8 + (4 * hi + ((lane & 15) >> 2)) * 64;
    float l = 0.f, m = 0.f; bool resc = false;
    f32x16 o[4];
#pragma unroll
    for (int i = 0; i < 4; ++i) o[i] = f32x16{};
    f32x16 pA0, pA1, pB0, pB1;
    bf16x8 kfr[4]; s16x4 vlo[4], vhi[4]; v4u pw[4];
    int vprev = 2 * SLV, vcur = 0, vnext = SLV;
#define D2_ROT() do { vprev = vcur; vcur = vnext; vnext = (vnext == 2 * SLV) ? 0 : vnext + SLV; } while (0)
#define D2_KF(kp_, i_) (*(const LAS bf16x8*)((kp_) + ((i_) >> 1) * 2048 + ((i_) & 1) * 512))
#define D2_VRD(vp_, slot_, j_) do { vlo[slot_] = vtr((vp_) + ((((j_) & 3) * 4 + ((j_) >> 2))) * 1024); vhi[slot_] = vtr((vp_) + ((((j_) & 3) * 4 + ((j_) >> 2))) * 1024 + 512); } while (0)
#define D2_VFR(slot_) (bf16x8){vlo[slot_][0], vlo[slot_][1], vlo[slot_][2], vlo[slot_][3], vhi[slot_][0], vhi[slot_][1], vhi[slot_][2], vhi[slot_][3]}
#define D2_PK(P, i_) cvtpk_s(P[i_], P[(i_) + 1])
#define D2_RESC() do { if (resc) { asm volatile("s_waitcnt lgkmcnt(0)" ::: "memory"); \
        _Pragma("unroll") for (int g_ = 0; g_ < 4; ++g_) { const f32x4 a4_ = *(const LAS f32x4*)(wsf + 8 * g_ + 4 * hi); \
            _Pragma("unroll") for (int blk_ = 0; blk_ < 4; ++blk_) _Pragma("unroll") for (int i_ = 0; i_ < 4; ++i_) o[blk_][4 * g_ + i_] *= a4_[i_]; } resc = false; } } while (0)
#define D2_CLOSE(t_) do { if ((t_) + 3 < NT) { D2_WAIT_BAR(4); } else if ((t_) + 1 < NT) { D2_WAIT_BAR(2); } else { D2_WAIT_BAR(0); } D2_RESC(); D2_ROT(); } while (0)
#define D2_ISSUE(t_) do { if ((t_) + 3 < NT) D2_DMA_K((t_) + 3, (((t_) + 3) & 3) * SLK); if ((t_) + 1 < NT) D2_DMA_V((t_) + 1, vnext); } while (0)
#define D2_GAPA(MF, RD, a0, a1, a2, a3, W0, W1, PWv) do { MF; RD; sacc += a0; sacc += a1; sacc += a2; sacc += a3; W0; W1; D2_PIN(PWv); D2_PIN(sacc); D2_SBAR(); } while (0)
#define D2_GAPB(MF, RD, X, i_) do { MF; RD; X[i_] = __builtin_amdgcn_exp2f(X[i_]); X[(i_) + 1] = __builtin_amdgcn_exp2f(X[(i_) + 1]); D2_PIN(X); D2_SBAR(); } while (0)
#define D2_SUMPACK(P0, P1) do { float sacc = 0.f; _Pragma("unroll") for (int r_ = 0; r_ < 16; ++r_) sacc += P0[r_] + P1[r_]; l += sacc; \
        _Pragma("unroll") for (int i_ = 0; i_ < 4; ++i_) { pw[0][i_] = D2_PK(P0, 2 * i_); pw[1][i_] = D2_PK(P0, 8 + 2 * i_); pw[2][i_] = D2_PK(P1, 2 * i_); pw[3][i_] = D2_PK(P1, 8 + 2 * i_); } } while (0)
#define D2_PHASEB(C0, C1, DOEXP, GL, kpn_) do { \
        D2_GAPB(o[0] = D2_MFMA(__builtin_bit_cast(bf16x8, pw[0]), D2_VFR(0), o[0]), D2_VRD(vp_, 0, 4),  C0, 0);  D2_GAPB(o[1] = D2_MFMA(__builtin_bit_cast(bf16x8, pw[0]), D2_VFR(1), o[1]), D2_VRD(vp_, 1, 5),  C0, 2); \
        D2_GAPB(o[2] = D2_MFMA(__builtin_bit_cast(bf16x8, pw[0]), D2_VFR(2), o[2]), D2_VRD(vp_, 2, 6),  C0, 4);  D2_GAPB(o[3] = D2_MFMA(__builtin_bit_cast(bf16x8, pw[0]), D2_VFR(3), o[3]), D2_VRD(vp_, 3, 7),  C0, 6); \
        D2_GAPB(o[0] = D2_MFMA(__builtin_bit_cast(bf16x8, pw[1]), D2_VFR(0), o[0]), D2_VRD(vp_, 0, 8),  C0, 8);  D2_GAPB(o[1] = D2_MFMA(__builtin_bit_cast(bf16x8, pw[1]), D2_VFR(1), o[1]), D2_VRD(vp_, 1, 9),  C0, 10); \
        D2_GAPB(o[2] = D2_MFMA(__builtin_bit_cast(bf16x8, pw[1]), D2_VFR(2), o[2]), D2_VRD(vp_, 2, 10), C0, 12); D2_GAPB(o[3] = D2_MFMA(__builtin_bit_cast(bf16x8, pw[1]), D2_VFR(3), o[3]), D2_VRD(vp_, 3, 11), C0, 14); \
        D2_GAPB(o[0] = D2_MFMA(__builtin_bit_cast(bf16x8, pw[2]), D2_VFR(0), o[0]), D2_VRD(vp_, 0, 12), C1, 0);  D2_GAPB(o[1] = D2_MFMA(__builtin_bit_cast(bf16x8, pw[2]), D2_VFR(1), o[1]), D2_VRD(vp_, 1, 13), C1, 2); \
        D2_GAPB(o[2] = D2_MFMA(__builtin_bit_cast(bf16x8, pw[2]), D2_VFR(2), o[2]), D2_VRD(vp_, 2, 14), C1, 4);  D2_GAPB(o[3] = D2_MFMA(__builtin_bit_cast(bf16x8, pw[2]), D2_VFR(3), o[3]), D2_VRD(vp_, 3, 15), C1, 6); \
        D2_GAPB(o[0] = D2_MFMA(__builtin_bit_cast(bf16x8, pw[3]), D2_VFR(0), o[0]), if (GL) kfr[0] = D2_KF(kpn_, 0), C1, 8);  D2_GAPB(o[1] = D2_MFMA(__builtin_bit_cast(bf16x8, pw[3]), D2_VFR(1), o[1]), if (GL) kfr[1] = D2_KF(kpn_, 1), C1, 10); \
        D2_GAPB(o[2] = D2_MFMA(__builtin_bit_cast(bf16x8, pw[3]), D2_VFR(2), o[2]), if (GL) kfr[2] = D2_KF(kpn_, 2), C1, 12); D2_GAPB(o[3] = D2_MFMA(__builtin_bit_cast(bf16x8, pw[3]), D2_VFR(3), o[3]), if (GL) kfr[3] = D2_KF(kpn_, 3), C1, 14); \
    } while (0)
#define D2_STEP(C0, C1, P0, P1, t_, GL) do { D2_SBAR(); \
        const LAS unsigned char* kp_ = kp0 + ((t_) & 3) * SLK; const LAS unsigned char* kpn_ = kp0 + (((t_) + 1) & 3) * SLK; const LAS unsigned char* vp_ = vp0 + vprev; \
        float sacc = P0[0] + P0[1]; \
        if constexpr (FAST) { C0 = f32x16{}; C1 = f32x16{}; } else \
        { const v2u on_ = {hi ? 0u : 0x3F80u, 0u}, qm_ = {hi ? 0u : (__builtin_bit_cast(unsigned, -m) >> 16), 0u};     \
          C0 = __builtin_amdgcn_mfma_f32_32x32x8bf16_1k(__builtin_bit_cast(s16x4, on_), __builtin_bit_cast(s16x4, qm_), (f32x16{}), 0, 0, 0); C1 = __builtin_amdgcn_mfma_f32_32x32x8bf16_1k(__builtin_bit_cast(s16x4, on_), __builtin_bit_cast(s16x4, qm_), (f32x16{}), 0, 0, 0); } \
        D2_GAPA(C0 = D2_MFMA(kfr[0], qr[0], C0), kfr[0] = D2_KF(kp_, 4), P0[2], P0[3], P0[4], P0[5],     pw[0][0] = D2_PK(P0, 0),  pw[0][1] = D2_PK(P0, 2),  pw[0]); \
        D2_GAPA(C1 = D2_MFMA(kfr[1], qr[0], C1), kfr[1] = D2_KF(kp_, 5), P0[6], P0[7], P0[8], P0[9],     pw[0][2] = D2_PK(P0, 4),  pw[0][3] = D2_PK(P0, 6),  pw[0]); \
        D2_GAPA(C0 = D2_MFMA(kfr[2], qr[1], C0),   kfr[2] = D2_KF(kp_, 6), P0[10], P0[11], P0[12], P0[13], pw[1][0] = D2_PK(P0, 8),  pw[1][1] = D2_PK(P0, 10), pw[1]); \
        D2_GAPA(C1 = D2_MFMA(kfr[3], qr[1], C1),   kfr[3] = D2_KF(kp_, 7), P0[14], P0[15], P1[0], P1[1],   pw[1][2] = D2_PK(P0, 12), pw[1][3] = D2_PK(P0, 14), pw[1]); \
        D2_GAPA(C0 = D2_MFMA(kfr[0], qr[2], C0),   D2_VRD(vp_, 0, 0),     P1[2], P1[3], P1[4], P1[5],     pw[2][0] = D2_PK(P1, 0),  pw[2][1] = D2_PK(P1, 2),  pw[2]); \
        D2_GAPA(C1 = D2_MFMA(kfr[1], qr[2], C1),   D2_VRD(vp_, 1, 1),     P1[6], P1[7], P1[8], P1[9],     pw[2][2] = D2_PK(P1, 4),  pw[2][3] = D2_PK(P1, 6),  pw[2]); \
        D2_GAPA(C0 = D2_MFMA(kfr[2], qr[3], C0),   D2_VRD(vp_, 2, 2),     P1[10], P1[11], P1[12], P1[13], pw[3][0] = D2_PK(P1, 8),  pw[3][1] = D2_PK(P1, 10), pw[3]); \
        D2_GAPA(C1 = D2_MFMA(kfr[3], qr[3], C1),   D2_VRD(vp_, 3, 3),     P1[14], P1[15], 0.f, 0.f,       pw[3][2] = D2_PK(P1, 12), pw[3][3] = D2_PK(P1, 14), pw[3]); \
        l += sacc; \
        D2_ISSUE(t_); \
        if constexpr (!FAST) { const float rm = rowmax(C0, C1);                                                \
          if (__builtin_expect(__any(rm > 8.f), 0)) { const float mn = bf2f(f2bf(m + __builtin_fmaxf(rm, 0.f))), d_ = mn - m, f = __builtin_amdgcn_exp2f(-d_); m = mn; l *= f; if (hi == 0) wsf[r32] = f; resc = true; \
              _Pragma("unroll") for (int r_ = 0; r_ < 16; ++r_) { C0[r_] -= d_; C1[r_] -= d_; } } } \
        D2_SBAR(); \
        D2_PHASEB(C0, C1, true, GL, kpn_); \
    } while (0)
#define D2_PVSTEP(P0, P1, t_) do { D2_SBAR(); const LAS unsigned char* vp_ = vp0 + vprev; \
        D2_VRD(vp_, 0, 0); D2_VRD(vp_, 1, 1); D2_VRD(vp_, 2, 2); D2_VRD(vp_, 3, 3); \
        D2_SUMPACK(P0, P1); D2_ISSUE(t_); \
        _Pragma("unroll") for (int j_ = 0; j_ < 16; ++j_) { o[j_ & 3] = D2_MFMA(__builtin_bit_cast(bf16x8, pw[j_ >> 2]), D2_VFR(j_ & 3), o[j_ & 3]); if (j_ + 4 < 16) D2_VRD(vp_, j_ & 3, j_ + 4); } \
    } while (0)

    D2_DMA_K(0, 0); D2_DMA_V(0, 0); D2_DMA_K(1, SLK);
    if (NT > 2) { D2_DMA_K(2, 2 * SLK); D2_WAIT_BAR(6); } else { D2_WAIT_BAR(4); }
    { const LAS unsigned char* kp_ = kp0;
      bf16x8 k8[8];
#pragma unroll
      for (int i = 0; i < 8; ++i) k8[i] = D2_KF(kp_, i);
      pA0 = D2_MFMA(k8[0], qr[0], (f32x16{})); pA1 = D2_MFMA(k8[1], qr[0], (f32x16{})); pA0 = D2_MFMA(k8[2], qr[1], pA0); pA1 = D2_MFMA(k8[3], qr[1], pA1);
      pA0 = D2_MFMA(k8[4], qr[2], pA0); pA1 = D2_MFMA(k8[5], qr[2], pA1); pA0 = D2_MFMA(k8[6], qr[3], pA0); pA1 = D2_MFMA(k8[7], qr[3], pA1);
      D2_ISSUE(0);
      if constexpr (!FAST) m = bf2f(f2bf(rowmax(pA0, pA1)));
#pragma unroll
      for (int r = 0; r < 16; ++r) { if constexpr (FAST) { pA0[r] = __builtin_amdgcn_exp2f(pA0[r]); pA1[r] = __builtin_amdgcn_exp2f(pA1[r]); } else { pA0[r] = __builtin_amdgcn_exp2f(pA0[r] - m); pA1[r] = __builtin_amdgcn_exp2f(pA1[r] - m); } }
    }
    if ((0) + 3 < NT) { D2_WAIT_BAR(4); } else { D2_WAIT_BAR(2); }
    D2_ROT();
    if (NT > 2 || full_last) {
#pragma unroll
        for (int i = 0; i < 4; ++i) kfr[i] = D2_KF(kp0 + SLK, i); }
    int t = 1;
    for (; t + 1 <= NT - 2; t += 2) {
        D2_STEP(pB0, pB1, pA0, pA1, t, true);                         D2_CLOSE(t);
        D2_STEP(pA0, pA1, pB0, pB1, t + 1, (full_last || t + 3 <= NT - 1)); D2_CLOSE(t + 1);
    }
    if (full_last) {
        D2_STEP(pB0, pB1, pA0, pA1, NT - 1, false); D2_CLOSE(NT - 1);
        D2_PVSTEP(pB0, pB1, NT); D2_WAIT_BAR(0);
    } else {
        D2_PVSTEP(pA0, pA1, NT - 1); D2_CLOSE(NT - 1);
        D2_WAIT_BAR(0);
    }
    unsigned ntk_ = 0u; if (tid == 448) ntk_ = __hip_atomic_fetch_add(qctr, 1u, __ATOMIC_RELAXED, __HIP_MEMORY_SCOPE_AGENT);
    l = hswap_sum(l);
    { const float inv = (sm ? lam : 1.f) / l;
      if (hi == 0) wsf[r32] = inv;
      asm volatile("s_waitcnt lgkmcnt(0)" ::: "memory");
#pragma unroll
      for (int g = 0; g < 4; ++g) { const f32x4 a4 = *(const LAS f32x4*)(wsf + 8 * g + 4 * hi);
#pragma unroll
          for (int blk = 0; blk < 4; ++blk)
#pragma unroll
              for (int i = 0; i < 4; ++i) o[blk][4 * g + i] *= a4[i]; } }
    constexpr int XP = 132;
    LAS float* X = (LAS float*)(lds + XOFF) + rb * (32 * XP);
    if (sm == 1) {
#pragma unroll
        for (int blk = 0; blk < 4; ++blk)
#pragma unroll
            for (int r = 0; r < 16; ++r) X[((r & 3) + 8 * (r >> 2) + 4 * hi) * XP + blk * 32 + r32] = o[blk][r];
    }
    D2_WAIT_BAR(0);
    if (sm == 0) {
#pragma unroll
        for (int blk = 0; blk < 4; ++blk)
#pragma unroll
            for (int r = 0; r < 16; ++r) { LAS float* xp = X + ((r & 3) + 8 * (r >> 2) + 4 * hi) * XP + blk * 32 + r32; *xp = o[blk][r] - *xp; }
    }
    asm volatile("s_waitcnt lgkmcnt(0)\n\ts_barrier" ::: "memory");
    { const int rg = lane >> 4, p = lane & 15;
      const f32x4 g0 = *(const f32x4*)(on_gain + 8 * p), g1 = *(const f32x4*)(on_gain + 8 * p + 4);
#pragma unroll
      for (int j = 0; j < 4; ++j) { const int row = 16 * sm + 4 * j + rg; const LAS float* xr = X + row * XP + 8 * p;
          const f32x4 v0 = *(const LAS f32x4*)xr, v1 = *(const LAS f32x4*)(xr + 4);
          float ss = ((v0[0] * v0[0] + v0[1] * v0[1]) + (v0[2] * v0[2] + v0[3] * v0[3])) + ((v1[0] * v1[0] + v1[1] * v1[1]) + (v1[2] * v1[2] + v1[3] * v1[3]));
          ss += __shfl_xor(ss, 1); ss += __shfl_xor(ss, 2); ss += __shfl_xor(ss, 4); ss += __shfl_xor(ss, 8);
          const float rstd = rsqrtf(ss * (1.f / 128.f) + EPS) * (1.f - LAM_INIT);
          st8(MIX + (rowbase + q0 + row) * 1024 + h * 128 + 8 * p, v0 * rstd * g0, v1 * rstd * g1); } }
    if (tid == 448) *qslot = ntk_;
    asm volatile("s_waitcnt lgkmcnt(0)\n\ts_barrier" ::: "memory");
}
}

namespace gla0 {
__device__ __forceinline__ void unit(LAS unsigned char* lds, int b, int h, const bf16* __restrict__ GQ, const bf16* __restrict__ GK, const bf16* __restrict__ GV, const bf16* __restrict__ GG, const float* __restrict__ GR,
                                     const float* __restrict__ gw, const float* __restrict__ gb, const float* __restrict__ on, bf16* MIX) {
    LAS float* q = (LAS float*)lds;
    LAS float* k = q + 4096; LAS float* EP = k + 4096; LAS float* v = EP + 4096;
    LAS float* Sst = v + 8192; LAS float* a = Sst + 8192; LAS float* Lmid = (LAS float*)(lds + XCH_OFF + 2048); LAS float* Lend = Lmid + 64;
    const int t = threadIdx.x; const size_t rowbase = (size_t)b * SEQ;
    for (int i = t; i < 8192; i += 512) Sst[i] = 0.f;
    for (int c = 0; c < 64; ++c) {
        __syncthreads();
        for (int i = t; i < 4096; i += 512) { const int r = i >> 6, d = i & 63; const size_t row = rowbase + c * 64 + r;
            q[i] = bf2f(GQ[row * 256 + h * 64 + d]); k[i] = bf2f(GK[row * 256 + h * 64 + d]);
            float z = gb[h * 64 + d];
#pragma unroll
            for (int rr = 0; rr < 16; ++rr) z += GR[row * 16 + rr] * gw[rr * 256 + h * 64 + d];
            const float ls = fminf(z, 0.f) - log1pf(expf(-fabsf(z)));
            EP[i] = ls * (1.f / 16.f); }
        for (int i = t; i < 8192; i += 512) { const int r = i >> 7, d = i & 127; v[i] = bf2f(GV[(rowbase + c * 64 + r) * 512 + h * 128 + d]); }
        __syncthreads();
        if (t < 64) { float s = 0.f; for (int r = 0; r < 64; ++r) { s += EP[r * 64 + t]; EP[r * 64 + t] = s; if (r == 31) Lmid[t] = s; } Lend[t] = s; }
        __syncthreads();
        for (int i = t; i < 4096; i += 512) { const int d = i & 63; const float lc = EP[i] - Lmid[d]; EP[i] = expf(lc); }
        __syncthreads();
        for (int i = t; i < 4096; i += 512) { const int ii = i >> 6, jj = i & 63; float s = 0.f;
            if (jj <= ii) { for (int d = 0; d < 64; ++d) s += q[ii * 64 + d] * EP[ii * 64 + d] * k[jj * 64 + d] / EP[jj * 64 + d]; }
            else          { for (int d = 0; d < 64; ++d) s += q[ii * 64 + d] / EP[ii * 64 + d] * k[jj * 64 + d] * EP[jj * 64 + d]; }
            a[i] = s; }
        __syncthreads();
        { const int ii = t >> 3, v0 = (t & 7) * 16; float o[16];
#pragma unroll
          for (int x = 0; x < 16; ++x) o[x] = 0.f;
          for (int j = 0; j < 64; ++j) { const float aij = a[ii * 64 + j];
#pragma unroll
              for (int x = 0; x < 16; ++x) o[x] += aij * v[j * 128 + v0 + x]; }
          for (int d = 0; d < 64; ++d) { const float qd = q[ii * 64 + d] * EP[ii * 64 + d] * expf(Lmid[d]);
#pragma unroll
              for (int x = 0; x < 16; ++x) o[x] += qd * Sst[d * 128 + v0 + x]; }
          float ss = 0.f;
#pragma unroll
          for (int x = 0; x < 16; ++x) ss += o[x] * o[x];
          ss += __shfl_xor(ss, 1); ss += __shfl_xor(ss, 2); ss += __shfl_xor(ss, 4);
          const float rs = rsqrtf(ss * (1.f / 128.f) + EPS);
          const size_t row = rowbase + c * 64 + ii;
          unsigned pk[8];
#pragma unroll
          for (int x = 0; x < 8; ++x) { const float g0 = bf2f(GG[row * 512 + h * 128 + v0 + 2 * x]), g1 = bf2f(GG[row * 512 + h * 128 + v0 + 2 * x + 1]);
              pk[x] = pk2(o[2 * x] * rs * on[v0 + 2 * x] * g0, o[2 * x + 1] * rs * on[v0 + 2 * x + 1] * g1); }
          v4u w0 = {pk[0], pk[1], pk[2], pk[3]}, w1 = {pk[4], pk[5], pk[6], pk[7]};
          *(v4u*)(MIX + row * 1024 + 512 + h * 128 + v0) = w0; *(v4u*)(MIX + row * 1024 + 512 + h * 128 + v0 + 8) = w1; }
        __syncthreads();
        { const int d = t >> 3, v0 = (t & 7) * 16; float u[16];
#pragma unroll
          for (int x = 0; x < 16; ++x) u[x] = 0.f;
          const float f = expf(Lend[d] - Lmid[d]);
          for (int j = 0; j < 64; ++j) { const float kd = k[j * 64 + d] / EP[j * 64 + d] * f;
#pragma unroll
              for (int x = 0; x < 16; ++x) u[x] += kd * v[j * 128 + v0 + x]; }
          const float dec = expf(Lend[d]);
#pragma unroll
          for (int x = 0; x < 16; ++x) Sst[d * 128 + v0 + x] = Sst[d * 128 + v0 + x] * dec + u[x]; }
    }
    __syncthreads();
}
}

namespace gla {
constexpr int T_QP = 0, T_QN = 8192, T_KP = 16384, T_KN = 24576, T_QL = 32768, T_KE = 40960, T_V = 49152  , T_S = 81920  , T_X = 114688  ;
constexpr int A_GW = 2048, A_DEC = 6144;
using da::s16x4; using da::vtr;
__device__ __forceinline__ float ex(float x) { return __builtin_amdgcn_exp2f(x * LOG2E); }
__device__ __forceinline__ float rdl(float v, int l) { return __builtin_bit_cast(float, __builtin_amdgcn_readlane(__builtin_bit_cast(int, v), l)); }
__device__ __forceinline__ void unit(LAS unsigned char* lds, LAS unsigned char* aux, int b, int h, const bf16* __restrict__ GQ, const bf16* __restrict__ GK, const bf16* __restrict__ GV, const bf16* __restrict__ GG, const float* __restrict__ GR,
                                     const float* __restrict__ gw, const float* __restrict__ gb, const float* __restrict__ on, bf16* MIX) {
    int tid_ = threadIdx.x; asm volatile("" : "+v"(tid_));
    const int tid = tid_, lane = tid & 63, r32 = lane & 31, hi = lane >> 5; const int wid = __builtin_amdgcn_readfirstlane(tid >> 6);
    const int ti = tid >> 3, vs = tid & 7, ib = wid >> 2, vb = wid & 3, dg = wid;
    const size_t rowbase = (size_t)b * SEQ;
    LAS float* GWL = (LAS float*)(aux + A_GW); LAS float* DEC = (LAS float*)(aux + A_DEC);
    LAS unsigned short* X = (LAS unsigned short*)(lds + T_X);
    for (int i = tid; i < 1024; i += 512) GWL[i] = gw[(i >> 6) * 256 + h * 64 + (i & 63)];
    float gbv[8], onv[16];
#pragma unroll
    for (int e = 0; e < 8; ++e) gbv[e] = gb[h * 64 + dg * 8 + e];
#pragma unroll
    for (int e = 0; e < 16; ++e) onv[e] = on[vs * 16 + e];
    { LAS v4u* z = (LAS v4u*)(lds + T_S); z[tid] = (v4u){0u, 0u, 0u, 0u}; z[tid + 512] = (v4u){0u, 0u, 0u, 0u}; }
    f32x16 S = f32x16{};
    const bf16* vsrc = GV + (rowbase + 16 * (wid & 3) + (lane >> 2)) * 512 + h * 128 + (wid >> 2) * 32 + (lane & 3) * 8;
#define GLA_VDMA(c_) do { const size_t go_ = (size_t)(c_) * 64 * 512; LAS unsigned char* vb_ = lds + T_V + ((c_) & 1) * 16384; \
        __builtin_amdgcn_global_load_lds((const unsigned*)(vsrc + go_), (LAS unsigned*)(vb_ + wid * 1024), 16, 0, 0); \
        __builtin_amdgcn_global_load_lds((const unsigned*)(vsrc + go_ + 64), (LAS unsigned*)(vb_ + (wid + 8) * 1024), 16, 0, 0); } while (0)
    size_t row = rowbase + lane;
    v4u qraw = *(const v4u*)(GQ + row * 256 + h * 64 + dg * 8), kraw = *(const v4u*)(GK + row * 256 + h * 64 + dg * 8);
    f32x4 grv[4];
#pragma unroll
    for (int i = 0; i < 4; ++i) grv[i] = *(const f32x4*)(GR + row * 16 + 4 * i);
    v4u gg0 = (v4u){0u, 0u, 0u, 0u}, gg1 = gg0;
    GLA_VDMA(0);
    __syncthreads();
    const int vpP = ((lane >> 4) & 1) * 32 + (lane & 3) * 8 + (4 * hi + ((lane & 15) >> 2)) * 64;
    const int vpN = ((lane >> 4) & 1) * 32 + (lane & 3) * 8 + (8 * hi + ((lane & 15) >> 2)) * 64;
#pragma unroll 1
    for (int c = 0; c <= 64; ++c) {
        if (c < 64) {
            float la[8];
#pragma unroll
            for (int e = 0; e < 8; ++e) la[e] = gbv[e];
#pragma unroll
            for (int r = 0; r < 16; ++r) { const f32x4 w0 = *(const LAS f32x4*)(GWL + r * 64 + dg * 8), w1 = *(const LAS f32x4*)(GWL + r * 64 + dg * 8 + 4); const float g = grv[r >> 2][r & 3];
#pragma unroll
                for (int e = 0; e < 4; ++e) { la[e] += g * w0[e]; la[4 + e] += g * w1[e]; } }
            const size_t rown = rowbase + (size_t)(c + 1) * 64 + lane;
            if (c < 63) {
#pragma unroll
                for (int i = 0; i < 4; ++i) grv[i] = *(const f32x4*)(GR + rown * 16 + 4 * i); }
#pragma unroll
            for (int e = 0; e < 8; ++e) { const float z = la[e]; la[e] = (fminf(z, 0.f) - __logf(1.f + ex(-fabsf(z)))) * (1.f / 16.f); }
            float midv[8], endv[8];
#pragma unroll
            for (int e = 0; e < 8; ++e) { float v = la[e];
                v += __builtin_bit_cast(float, __builtin_amdgcn_update_dpp(0, __builtin_bit_cast(int, v), 0x111, 0xf, 0xf, true));
                v += __builtin_bit_cast(float, __builtin_amdgcn_update_dpp(0, __builtin_bit_cast(int, v), 0x112, 0xf, 0xf, true));
                v += __builtin_bit_cast(float, __builtin_amdgcn_update_dpp(0, __builtin_bit_cast(int, v), 0x114, 0xf, 0xf, true));
                v += __builtin_bit_cast(float, __builtin_amdgcn_update_dpp(0, __builtin_bit_cast(int, v), 0x118, 0xf, 0xf, true));
                const float t0 = rdl(v, 15), t1 = rdl(v, 31), t2 = rdl(v, 47), t3 = rdl(v, 63);
                const float add = (lane < 16) ? 0.f : (lane < 32) ? t0 : (lane < 48) ? (t0 + t1) : (t0 + t1 + t2);
                la[e] = v + add; midv[e] = t0 + t1; endv[e] = (t0 + t1) + (t2 + t3); }
            float qf[8], kf[8];
#pragma unroll
            for (int e = 0; e < 4; ++e) { qf[2 * e] = __builtin_bit_cast(float, qraw[e] << 16); qf[2 * e + 1] = __builtin_bit_cast(float, qraw[e] & 0xffff0000u); kf[2 * e] = __builtin_bit_cast(float, kraw[e] << 16); kf[2 * e + 1] = __builtin_bit_cast(float, kraw[e] & 0xffff0000u); }
            if (c < 63) { qraw = *(const v4u*)(GQ + rown * 256 + h * 64 + dg * 8); kraw = *(const v4u*)(GK + rown * 256 + h * 64 + dg * 8); }
            float qp[8], qn[8], kp[8], kn[8], ql[8], ke[8];
#pragma unroll
            for (int e = 0; e < 8; ++e) { const float mid = midv[e], end = endv[e];
                const float lc = la[e] - mid, ep = ex(lc), en = ex(-lc), fm = ex(mid), fe = ex(end - mid);
                qp[e] = qf[e] * ep; qn[e] = qf[e] * en; kp[e] = kf[e] * ep; kn[e] = kf[e] * en; ql[e] = qp[e] * fm; ke[e] = kn[e] * fe;
                if (lane == 0) DEC[dg * 8 + e] = ex(end); }
            const int to = dg * 1024 + lane * 16;
            *(LAS v4u*)(lds + T_QP + to) = (v4u){cvt_pk_bf16(qp[0], qp[1]), cvt_pk_bf16(qp[2], qp[3]), cvt_pk_bf16(qp[4], qp[5]), cvt_pk_bf16(qp[6], qp[7])};
            *(LAS v4u*)(lds + T_QN + to) = (v4u){cvt_pk_bf16(qn[0], qn[1]), cvt_pk_bf16(qn[2], qn[3]), cvt_pk_bf16(qn[4], qn[5]), cvt_pk_bf16(qn[6], qn[7])};
            *(LAS v4u*)(lds + T_KP + to) = (v4u){cvt_pk_bf16(kp[0], kp[1]), cvt_pk_bf16(kp[2], kp[3]), cvt_pk_bf16(kp[4], kp[5]), cvt_pk_bf16(kp[6], kp[7])};
            *(LAS v4u*)(lds + T_KN + to) = (v4u){cvt_pk_bf16(kn[0], kn[1]), cvt_pk_bf16(kn[2], kn[3]), cvt_pk_bf16(kn[4], kn[5]), cvt_pk_bf16(kn[6], kn[7])};
            *(LAS v4u*)(lds + T_QL + to) = (v4u){cvt_pk_bf16(ql[0], ql[1]), cvt_pk_bf16(ql[2], ql[3]), cvt_pk_bf16(ql[4], ql[5]), cvt_pk_bf16(ql[6], ql[7])};
            *(LAS v4u*)(lds + T_KE + to) = (v4u){cvt_pk_bf16(ke[0], ke[1]), cvt_pk_bf16(ke[2], ke[3]), cvt_pk_bf16(ke[4], ke[5]), cvt_pk_bf16(ke[6], ke[7])};
        }
        if (c > 0) {
            const LAS v4u* xr = (const LAS v4u*)(X + ti * 128 + vs * 16);
            f32x4 o4[4]; float ss = 0.f;
#pragma unroll
            for (int i = 0; i < 2; ++i) { const v4u xw = xr[i];
#pragma unroll
                for (int e = 0; e < 2; ++e) { o4[2 * i + e] = (f32x4){__builtin_bit_cast(float, xw[2 * e] << 16), __builtin_bit_cast(float, xw[2 * e] & 0xffff0000u), __builtin_bit_cast(float, xw[2 * e + 1] << 16), __builtin_bit_cast(float, xw[2 * e + 1] & 0xffff0000u)}; } }
#pragma unroll
            for (int i = 0; i < 4; ++i) ss += (o4[i][0] * o4[i][0] + o4[i][1] * o4[i][1]) + (o4[i][2] * o4[i][2] + o4[i][3] * o4[i][3]);
            ss += __shfl_xor(ss, 1); ss += __shfl_xor(ss, 2); ss += __shfl_xor(ss, 4);
            const float rs = rsqrtf(ss * (1.f / 128.f) + EPS);
            float gf[16];
#pragma unroll
            for (int e = 0; e < 4; ++e) { gf[2 * e] = __builtin_bit_cast(float, gg0[e] << 16); gf[2 * e + 1] = __builtin_bit_cast(float, gg0[e] & 0xffff0000u); gf[8 + 2 * e] = __builtin_bit_cast(float, gg1[e] << 16); gf[9 + 2 * e] = __builtin_bit_cast(float, gg1[e] & 0xffff0000u); }
            v4u w0, w1;
#pragma unroll
            for (int e = 0; e < 4; ++e) { w0[e] = cvt_pk_bf16(o4[e >> 1][(2 * e) & 3] * rs * onv[2 * e] * gf[2 * e], o4[e >> 1][(2 * e + 1) & 3] * rs * onv[2 * e + 1] * gf[2 * e + 1]);
                w1[e] = cvt_pk_bf16(o4[2 + (e >> 1)][(2 * e) & 3] * rs * onv[8 + 2 * e] * gf[8 + 2 * e], o4[2 + (e >> 1)][(2 * e + 1) & 3] * rs * onv[9 + 2 * e] * gf[9 + 2 * e]); }
            bf16* op = MIX + (rowbase + (size_t)(c - 1) * 64 + ti) * 1024 + 512 + h * 128 + vs * 16;
            *(v4u*)op = w0; *(v4u*)(op + 8) = w1;
        }
        if (c == 64) break;
        if (c == 0) asm volatile("s_waitcnt vmcnt(6) lgkmcnt(0)\n\ts_barrier" ::: "memory");
        else if (c == 63) asm volatile("s_waitcnt vmcnt(2) lgkmcnt(0)\n\ts_barrier" ::: "memory");
        else asm volatile("s_waitcnt vmcnt(8) lgkmcnt(0)\n\ts_barrier" ::: "memory");
        { const size_t rg = rowbase + (size_t)c * 64 + ti; gg0 = *(const v4u*)(GG + rg * 512 + h * 128 + vs * 16); gg1 = *(const v4u*)(GG + rg * 512 + h * 128 + vs * 16 + 8); }
        if (c < 63) GLA_VDMA(c + 1);
        f32x16 O = f32x16{};
        {
            const LAS unsigned char* fq_ = lds + hi * 1024 + (32 * ib + r32) * 16;
            v4u pw[2][2];
#pragma unroll
            for (int jb = 0; jb < 2; ++jb) {
                const LAS unsigned char* fk_ = lds + hi * 1024 + (32 * jb + r32) * 16;
                f32x16 past = f32x16{}, fut = f32x16{};
                if (jb <= ib) {
#pragma unroll
                    for (int d0 = 0; d0 < 4; ++d0) past = __builtin_amdgcn_mfma_f32_32x32x16_bf16(*(const LAS bf16x8*)(fk_ + T_KN + d0 * 2048), *(const LAS bf16x8*)(fq_ + T_QP + d0 * 2048), past, 0, 0, 0); }
                if (jb >= ib) {
#pragma unroll
                    for (int d0 = 0; d0 < 4; ++d0) fut = __builtin_amdgcn_mfma_f32_32x32x16_bf16(*(const LAS bf16x8*)(fk_ + T_KP + d0 * 2048), *(const LAS bf16x8*)(fq_ + T_QN + d0 * 2048), fut, 0, 0, 0); }
                f32x16 a;
                if (jb < ib) a = past; else if (jb > ib) a = fut; else {
#pragma unroll
                    for (int r = 0; r < 16; ++r) a[r] = (((r & 3) + 8 * (r >> 2) + 4 * hi) <= r32) ? past[r] : fut[r]; }
#pragma unroll
                for (int i = 0; i < 4; ++i) { pw[jb][0][i] = cvtpk_s(a[2 * i], a[2 * i + 1]); pw[jb][1][i] = cvtpk_s(a[8 + 2 * i], a[9 + 2 * i]); }
            }
#pragma unroll
            for (int jb = 0; jb < 2; ++jb)
#pragma unroll
                for (int s = 0; s < 2; ++s) { const LAS unsigned char* vp = lds + T_V + (c & 1) * 16384 + (vb * 4 + 2 * jb + s) * 1024 + vpP;
                    const s16x4 lo = vtr(vp), hh = vtr(vp + 512);
                    O = __builtin_amdgcn_mfma_f32_32x32x16_bf16(__builtin_bit_cast(bf16x8, pw[jb][s]), (bf16x8){lo[0], lo[1], lo[2], lo[3], hh[0], hh[1], hh[2], hh[3]}, O, 0, 0, 0); }
            const LAS unsigned char* sp = lds + T_S + (c & 1) * 16384 + hi * 2048 + (32 * vb + r32) * 16;
#pragma unroll
            for (int s = 0; s < 4; ++s)
                O = __builtin_amdgcn_mfma_f32_32x32x16_bf16(*(const LAS bf16x8*)(fq_ + T_QL + s * 2048), *(const LAS bf16x8*)(sp + s * 4096), O, 0, 0, 0);
            f32x16 U = f32x16{};
            const int kd0 = 32 * ib + 16 * ((lane >> 4) & 1) + 4 * (lane & 3);
            const LAS unsigned char* kep = lds + T_KE + (kd0 >> 3) * 1024 + (8 * hi + ((lane & 15) >> 2)) * 16 + (kd0 & 7) * 2;
            const LAS unsigned char* vn = lds + T_V + (c & 1) * 16384 + vb * 4096 + vpN;
#pragma unroll
            for (int s = 0; s < 4; ++s) { const s16x4 lo = vtr(vn + s * 1024), hh = vtr(vn + s * 1024 + 256);
                const s16x4 kl = vtr(kep + s * 256), kh = vtr(kep + s * 256 + 64);
                U = __builtin_amdgcn_mfma_f32_32x32x16_bf16((bf16x8){kl[0], kl[1], kl[2], kl[3], kh[0], kh[1], kh[2], kh[3]}, (bf16x8){lo[0], lo[1], lo[2], lo[3], hh[0], hh[1], hh[2], hh[3]}, U, 0, 0, 0); }
            LAS unsigned char* sw = lds + T_S + ((c + 1) & 1) * 16384 + (32 * vb + r32) * 16 + 8 * hi;
#pragma unroll
            for (int g = 0; g < 4; ++g) { const f32x4 d4 = *(const LAS f32x4*)(DEC + 32 * ib + 8 * g + 4 * hi);
#pragma unroll
                for (int i = 0; i < 4; ++i) { const int r = 4 * g + i; S[r] = S[r] * d4[i] + U[r];
                    X[(32 * ib + 8 * g + 4 * hi + i) * 128 + 32 * vb + r32] = (unsigned short)f2bf(O[r]); }
                *(LAS v2u*)(sw + (4 * ib + g) * 2048) = (v2u){cvtpk_s(S[4 * g], S[4 * g + 1]), cvtpk_s(S[4 * g + 2], S[4 * g + 3])}; }
        }
        asm volatile("s_waitcnt lgkmcnt(0)\n\ts_barrier" ::: "memory");
    }
    asm volatile("s_waitcnt vmcnt(0) lgkmcnt(0)\n\ts_barrier" ::: "memory");
#undef GLA_VDMA
}
}

namespace gla2 {
constexpr int T_QP = 0, T_QN = 8192, T_KP = 16384, T_KN = 24576, T_KE = 32768, T_V = 40960;
constexpr int S_QL = 0  , S_ST = 24576  , S_X = 57344  , S_DEC = 90112  ;
using da::s16x4; using da::vtr; using gla::ex; using gla::rdl;

__device__ __forceinline__ void prep_units(LAS unsigned char* lds, LAS unsigned char* aux, int u0, int ustep, int uend, const bf16* __restrict__ GQ, const bf16* __restrict__ GK, const bf16* __restrict__ GV, const float* __restrict__ GR,
                                           const float* __restrict__ gw, const float* __restrict__ gb, unsigned char* QLG, unsigned char* OIG, unsigned char* UG, float* DECG) {
    int tid_ = threadIdx.x; asm volatile("" : "+v"(tid_));
    const int tid = tid_, lane = tid & 63, r32 = lane & 31, hi = lane >> 5; const int wid = __builtin_amdgcn_readfirstlane(tid >> 6);
    const int ib = wid >> 2, vb = wid & 3, dg = wid;
    if (u0 >= uend) return;
    const int h = (u0 >> 6) & 3;
    LAS float* GWL = (LAS float*)(aux + 2048);
    for (int i = tid; i < 1024; i += 512) GWL[i] = gw[(i >> 6) * 256 + h * 64 + (i & 63)];
    float gbv[8];
#pragma unroll
    for (int e = 0; e < 8; ++e) gbv[e] = gb[h * 64 + dg * 8 + e];
    v4u qraw, kraw; f32x4 grv[4];
    { const int c0 = u0 & 63, b0 = u0 >> 8; const size_t row0 = (size_t)b0 * SEQ + (size_t)c0 * 64 + lane;
      const bf16* vsrc = GV + ((size_t)b0 * SEQ + (size_t)c0 * 64 + 16 * (wid & 3) + (lane >> 2)) * 512 + h * 128 + (wid >> 2) * 32 + (lane & 3) * 8;
      __builtin_amdgcn_global_load_lds((const unsigned*)vsrc, (LAS unsigned*)(lds + T_V + wid * 1024), 16, 0, 0);
      __builtin_amdgcn_global_load_lds((const unsigned*)(vsrc + 64), (LAS unsigned*)(lds + T_V + (wid + 8) * 1024), 16, 0, 0);
      qraw = *(const v4u*)(GQ + row0 * 256 + h * 64 + dg * 8); kraw = *(const v4u*)(GK + row0 * 256 + h * 64 + dg * 8);
#pragma unroll
      for (int i = 0; i < 4; ++i) grv[i] = *(const f32x4*)(GR + row0 * 16 + 4 * i); }
    __syncthreads();
    int vsel = 0;
#pragma unroll 1
    for (int u = u0; u < uend; u += ustep) {
    float la[8];
#pragma unroll
    for (int e = 0; e < 8; ++e) la[e] = gbv[e];
#pragma unroll
    for (int r = 0; r < 16; ++r) { const f32x4 w0 = *(const LAS f32x4*)(GWL + r * 64 + dg * 8), w1 = *(const LAS f32x4*)(GWL + r * 64 + dg * 8 + 4); const float g = grv[r >> 2][r & 3];
#pragma unroll
        for (int e = 0; e < 4; ++e) { la[e] += g * w0[e]; la[4 + e] += g * w1[e]; } }
#pragma unroll
    for (int e = 0; e < 8; ++e) { const float z = la[e]; la[e] = (fminf(z, 0.f) - __logf(1.f + ex(-fabsf(z)))) * (1.f / 16.f); }
    float midv[8], endv[8]; v4u qlpk;
#pragma unroll
    for (int e = 0; e < 8; ++e) { float v = la[e];
        v += __builtin_bit_cast(float, __builtin_amdgcn_update_dpp(0, __builtin_bit_cast(int, v), 0x111, 0xf, 0xf, true));
        v += __builtin_bit_cast(float, __builtin_amdgcn_update_dpp(0, __builtin_bit_cast(int, v), 0x112, 0xf, 0xf, true));
        v += __builtin_bit_cast(float, __builtin_amdgcn_update_dpp(0, __builtin_bit_cast(int, v), 0x114, 0xf, 0xf, true));
        v += __builtin_bit_cast(float, __builtin_amdgcn_update_dpp(0, __builtin_bit_cast(int, v), 0x118, 0xf, 0xf, true));
        const float t0 = rdl(v, 15), t1 = rdl(v, 31), t2 = rdl(v, 47), t3 = rdl(v, 63);
        const float add = (lane < 16) ? 0.f : (lane < 32) ? t0 : (lane < 48) ? (t0 + t1) : (t0 + t1 + t2);
        la[e] = v + add; midv[e] = t0 + t1; endv[e] = (t0 + t1) + (t2 + t3); }
    { float qf[8], kf[8];
#pragma unroll
      for (int e = 0; e < 4; ++e) { qf[2 * e] = __builtin_bit_cast(float, qraw[e] << 16); qf[2 * e + 1] = __builtin_bit_cast(float, qraw[e] & 0xffff0000u); kf[2 * e] = __builtin_bit_cast(float, kraw[e] << 16); kf[2 * e + 1] = __builtin_bit_cast(float, kraw[e] & 0xffff0000u); }
      float qp[8], qn[8], kp[8], kn[8], ql[8], ke[8];
#pragma unroll
      for (int e = 0; e < 8; ++e) { const float mid = midv[e], end = endv[e];
          const float lc = la[e] - mid, ep = ex(lc), en = ex(-lc), fm = ex(mid), fe = ex(end - mid);
          qp[e] = qf[e] * ep; qn[e] = qf[e] * en; kp[e] = kf[e] * ep; kn[e] = kf[e] * en; ql[e] = qp[e] * fm; ke[e] = kn[e] * fe; }
      const int to = dg * 1024 + lane * 16;
      *(LAS v4u*)(lds + T_QP + to) = (v4u){cvt_pk_bf16(qp[0], qp[1]), cvt_pk_bf16(qp[2], qp[3]), cvt_pk_bf16(qp[4], qp[5]), cvt_pk_bf16(qp[6], qp[7])};
      *(LAS v4u*)(lds + T_QN + to) = (v4u){cvt_pk_bf16(qn[0], qn[1]), cvt_pk_bf16(qn[2], qn[3]), cvt_pk_bf16(qn[4], qn[5]), cvt_pk_bf16(qn[6], qn[7])};
      *(LAS v4u*)(lds + T_KP + to) = (v4u){cvt_pk_bf16(kp[0], kp[1]), cvt_pk_bf16(kp[2], kp[3]), cvt_pk_bf16(kp[4], kp[5]), cvt_pk_bf16(kp[6], kp[7])};
      *(LAS v4u*)(lds + T_KN + to) = (v4u){cvt_pk_bf16(kn[0], kn[1]), cvt_pk_bf16(kn[2], kn[3]), cvt_pk_bf16(kn[4], kn[5]), cvt_pk_bf16(kn[6], kn[7])};
      *(LAS v4u*)(lds + T_KE + to) = (v4u){cvt_pk_bf16(ke[0], ke[1]), cvt_pk_bf16(ke[2], ke[3]), cvt_pk_bf16(ke[4], ke[5]), cvt_pk_bf16(ke[6], ke[7])};
      qlpk = (v4u){cvt_pk_bf16(ql[0], ql[1]), cvt_pk_bf16(ql[2], ql[3]), cvt_pk_bf16(ql[4], ql[5]), cvt_pk_bf16(ql[6], ql[7])}; }
    if (u + ustep < uend) { const int un = u + ustep; const int cn = un & 63, bn = un >> 8; const size_t rown = (size_t)bn * SEQ + (size_t)cn * 64 + lane;
        qraw = *(const v4u*)(GQ + rown * 256 + h * 64 + dg * 8); kraw = *(const v4u*)(GK + rown * 256 + h * 64 + dg * 8);
#pragma unroll
        for (int i = 0; i < 4; ++i) grv[i] = *(const f32x4*)(GR + rown * 16 + 4 * i);
        const bf16* vsrc = GV + ((size_t)bn * SEQ + (size_t)cn * 64 + 16 * (wid & 3) + (lane >> 2)) * 512 + h * 128 + (wid >> 2) * 32 + (lane & 3) * 8;
        LAS unsigned char* vbn = lds + T_V + (vsel ^ 1) * 16384;
        __builtin_amdgcn_global_load_lds((const unsigned*)vsrc, (LAS unsigned*)(vbn + wid * 1024), 16, 0, 0);
        __builtin_amdgcn_global_load_lds((const unsigned*)(vsrc + 64), (LAS unsigned*)(vbn + (wid + 8) * 1024), 16, 0, 0);
        asm volatile("s_waitcnt vmcnt(12) lgkmcnt(0)\n\ts_barrier" ::: "memory"); }
    else asm volatile("s_waitcnt vmcnt(0) lgkmcnt(0)\n\ts_barrier" ::: "memory");
    *(v4u*)(QLG + (size_t)u * 8192 + dg * 1024 + lane * 16) = qlpk;
    if (lane == 0) { f32x4 d0_, d1_;
#pragma unroll
        for (int e = 0; e < 4; ++e) { d0_[e] = ex(endv[e]); d1_[e] = ex(endv[4 + e]); }
        *(f32x4*)(DECG + (size_t)u * 64 + dg * 8) = d0_; *(f32x4*)(DECG + (size_t)u * 64 + dg * 8 + 4) = d1_; }
    const int vpP = ((lane >> 4) & 1) * 32 + (lane & 3) * 8 + (4 * hi + ((lane & 15) >> 2)) * 64;
    const int vpN = ((lane >> 4) & 1) * 32 + (lane & 3) * 8 + (8 * hi + ((lane & 15) >> 2)) * 64;
    f32x16 O = f32x16{}, U = f32x16{};
    { const LAS unsigned char* fq_ = lds + hi * 1024 + (32 * ib + r32) * 16;
      v4u pw[2][2];
#pragma unroll
      for (int jb = 0; jb < 2; ++jb) {
          const LAS unsigned char* fk_ = lds + hi * 1024 + (32 * jb + r32) * 16;
          f32x16 past = f32x16{}, fut = f32x16{};
          if (jb <= ib) {
#pragma unroll
              for (int d0 = 0; d0 < 4; ++d0) past = __builtin_amdgcn_mfma_f32_32x32x16_bf16(*(const LAS bf16x8*)(fk_ + T_KN + d0 * 2048), *(const LAS bf16x8*)(fq_ + T_QP + d0 * 2048), past, 0, 0, 0); }
          if (jb >= ib) {
#pragma unroll
              for (int d0 = 0; d0 < 4; ++d0) fut = __builtin_amdgcn_mfma_f32_32x32x16_bf16(*(const LAS bf16x8*)(fk_ + T_KP + d0 * 2048), *(const LAS bf16x8*)(fq_ + T_QN + d0 * 2048), fut, 0, 0, 0); }
          f32x16 a;
          if (jb < ib) a = past; else if (jb > ib) a = fut; else {
#pragma unroll
              for (int r = 0; r < 16; ++r) a[r] = (((r & 3) + 8 * (r >> 2) + 4 * hi) <= r32) ? past[r] : fut[r]; }
#pragma unroll
          for (int i = 0; i < 4; ++i) { pw[jb][0][i] = cvtpk_s(a[2 * i], a[2 * i + 1]); pw[jb][1][i] = cvtpk_s(a[8 + 2 * i], a[9 + 2 * i]); }
      }
#pragma unroll
      for (int jb = 0; jb < 2; ++jb)
#pragma unroll
          for (int s = 0; s < 2; ++s) { const LAS unsigned char* vp = lds + T_V + vsel * 16384 + (vb * 4 + 2 * jb + s) * 1024 + vpP;
              const s16x4 lo = vtr(vp), hh = vtr(vp + 512);
              O = __builtin_amdgcn_mfma_f32_32x32x16_bf16(__builtin_bit_cast(bf16x8, pw[jb][s]), (bf16x8){lo[0], lo[1], lo[2], lo[3], hh[0], hh[1], hh[2], hh[3]}, O, 0, 0, 0); }
      const int kd0 = 32 * ib + 16 * ((lane >> 4) & 1) + 4 * (lane & 3);
      const LAS unsigned char* kep = lds + T_KE + (kd0 >> 3) * 1024 + (8 * hi + ((lane & 15) >> 2)) * 16 + (kd0 & 7) * 2;
      const LAS unsigned char* vn = lds + T_V + vsel * 16384 + vb * 4096 + vpN;
#pragma unroll
      for (int s = 0; s < 4; ++s) { const s16x4 lo = vtr(vn + s * 1024), hh = vtr(vn + s * 1024 + 256); const s16x4 kl = vtr(kep + s * 256), kh = vtr(kep + s * 256 + 64);
          U = __builtin_amdgcn_mfma_f32_32x32x16_bf16((bf16x8){kl[0], kl[1], kl[2], kl[3], kh[0], kh[1], kh[2], kh[3]}, (bf16x8){lo[0], lo[1], lo[2], lo[3], hh[0], hh[1], hh[2], hh[3]}, U, 0, 0, 0); } }
    { v4u* od = (v4u*)(OIG + (size_t)u * 16384 + wid * 2048 + lane * 32); v4u* ud = (v4u*)(UG + (size_t)u * 16384 + wid * 2048 + lane * 32);
      od[0] = (v4u){cvtpk_s(O[0], O[1]), cvtpk_s(O[2], O[3]), cvtpk_s(O[4], O[5]), cvtpk_s(O[6], O[7])}; od[1] = (v4u){cvtpk_s(O[8], O[9]), cvtpk_s(O[10], O[11]), cvtpk_s(O[12], O[13]), cvtpk_s(O[14], O[15])};
      ud[0] = (v4u){cvtpk_s(U[0], U[1]), cvtpk_s(U[2], U[3]), cvtpk_s(U[4], U[5]), cvtpk_s(U[6], U[7])}; ud[1] = (v4u){cvtpk_s(U[8], U[9]), cvtpk_s(U[10], U[11]), cvtpk_s(U[12], U[13]), cvtpk_s(U[14], U[15])}; }
    asm volatile("s_waitcnt lgkmcnt(0)\n\ts_barrier" ::: "memory");
    vsel ^= 1;
    }
}
__device__ __forceinline__ void seq_unit(LAS unsigned char* lds, int bh, const bf16* __restrict__ GG, const float* __restrict__ on, const unsigned char* QLG, const unsigned char* OIG, const unsigned char* UG, const float* DECG, bf16* MIX) {
    int tid_ = threadIdx.x; asm volatile("" : "+v"(tid_));
    const int tid = tid_, lane = tid & 63, r32 = lane & 31, hi = lane >> 5; const int wid = __builtin_amdgcn_readfirstlane(tid >> 6);
    const int ti = tid >> 3, vs = tid & 7, ib = wid >> 2, vb = wid & 3;
    const int b = bh >> 2, h = bh & 3; const size_t rowbase = (size_t)b * SEQ; const size_t u0 = (size_t)bh * 64;
    float onv[16];
#pragma unroll
    for (int e = 0; e < 16; ++e) onv[e] = on[vs * 16 + e];
    { LAS v4u* z = (LAS v4u*)(lds + S_ST); z[tid] = (v4u){0u, 0u, 0u, 0u}; z[tid + 512] = (v4u){0u, 0u, 0u, 0u}; }
    f32x16 S = f32x16{};
#define SQ_QLDMA(c_) __builtin_amdgcn_global_load_lds((const unsigned*)(QLG + (u0 + (c_)) * 8192 + wid * 1024 + lane * 16), (LAS unsigned*)(lds + S_QL + ((c_) % 3) * 8192 + wid * 1024), 16, 0, 0)
#define SQ_DECDMA(c_) __builtin_amdgcn_global_load_lds((const unsigned*)(DECG + (u0 + (c_)) * 64 + lane), (LAS unsigned*)(lds + S_DEC + ((c_) % 3) * 256), 4, 0, 0)
    SQ_QLDMA(0); SQ_DECDMA(0); SQ_QLDMA(1); SQ_DECDMA(1);
    v4u oiA0, oiA1, uuA0, uuA1, ggA0, ggA1, oiB0, oiB1, uuB0, uuB1, ggB0, ggB1, oiC0, oiC1, uuC0, uuC1, ggC0, ggC1;
#define SQ_LOAD(c_, X) do { const size_t uo_ = (u0 + (c_)) * 16384 + wid * 2048 + lane * 32; oi##X##0 = *(const v4u*)(OIG + uo_); oi##X##1 = *(const v4u*)(OIG + uo_ + 16); uu##X##0 = *(const v4u*)(UG + uo_); uu##X##1 = *(const v4u*)(UG + uo_ + 16); \
        { const size_t rg_ = rowbase + (size_t)(c_) * 64 + ti; gg##X##0 = *(const v4u*)(GG + rg_ * 512 + h * 128 + vs * 16); gg##X##1 = *(const v4u*)(GG + rg_ * 512 + h * 128 + vs * 16 + 8); } } while (0)
    SQ_LOAD(0, A); SQ_LOAD(1, B);
    v4u pg0 = (v4u){0u, 0u, 0u, 0u}, pg1 = pg0;
#define SQ_ITER(c_, X, Y) { const int c = (c_); \
        if (c >= 2 && c <= 62) asm volatile("s_waitcnt vmcnt(10) lgkmcnt(0)\n\ts_barrier" ::: "memory"); else asm volatile("s_waitcnt vmcnt(0) lgkmcnt(0)\n\ts_barrier" ::: "memory"); \
        if (c < 64) { \
            if (c < 62) { SQ_QLDMA(c + 2); SQ_DECDMA(c + 2); } \
            if (c < 62) SQ_LOAD(c + 2, Y); \
        } \
        if (c > 0) {     \
            const LAS v4u* xr = (const LAS v4u*)(lds + S_X + ((c - 1) & 1) * 16384 + (ti * 128 + vs * 16) * 2); \
            f32x4 o4[4]; float ss = 0.f; \
            _Pragma("unroll") for (int i = 0; i < 2; ++i) { const v4u xw = xr[i]; \
                _Pragma("unroll") for (int e = 0; e < 2; ++e) o4[2 * i + e] = (f32x4){__builtin_bit_cast(float, xw[2 * e] << 16), __builtin_bit_cast(float, xw[2 * e] & 0xffff0000u), __builtin_bit_cast(float, xw[2 * e + 1] << 16), __builtin_bit_cast(float, xw[2 * e + 1] & 0xffff0000u)}; } \
            _Pragma("unroll") for (int i = 0; i < 4; ++i) ss += (o4[i][0] * o4[i][0] + o4[i][1] * o4[i][1]) + (o4[i][2] * o4[i][2] + o4[i][3] * o4[i][3]); \
            ss += __shfl_xor(ss, 1); ss += __shfl_xor(ss, 2); ss += __shfl_xor(ss, 4); \
            const float rs = rsqrtf(ss * (1.f / 128.f) + EPS); \
            float gf[16]; \
            _Pragma("unroll") for (int e = 0; e < 4; ++e) { gf[2 * e] = __builtin_bit_cast(float, pg0[e] << 16); gf[2 * e + 1] = __builtin_bit_cast(float, pg0[e] & 0xffff0000u); gf[8 + 2 * e] = __builtin_bit_cast(float, pg1[e] << 16); gf[9 + 2 * e] = __builtin_bit_cast(float, pg1[e] & 0xffff0000u); } \
            v4u w0, w1; \
            _Pragma("unroll") for (int e = 0; e < 4; ++e) { w0[e] = cvt_pk_bf16(o4[e >> 1][(2 * e) & 3] * rs * onv[2 * e] * gf[2 * e], o4[e >> 1][(2 * e + 1) & 3] * rs * onv[2 * e + 1] * gf[2 * e + 1]); \
                w1[e] = cvt_pk_bf16(o4[2 + (e >> 1)][(2 * e) & 3] * rs * onv[8 + 2 * e] * gf[8 + 2 * e], o4[2 + (e >> 1)][(2 * e + 1) & 3] * rs * onv[9 + 2 * e] * gf[9 + 2 * e]); } \
            bf16* op = MIX + (rowbase + (size_t)(c - 1) * 64 + ti) * 1024 + 512 + h * 128 + vs * 16; \
            *(v4u*)op = w0; *(v4u*)(op + 8) = w1; \
        } \
        if (c == 64) goto sq_done_; \
          \
        f32x16 O; \
        _Pragma("unroll") for (int i = 0; i < 4; ++i) { O[2 * i] = __builtin_bit_cast(float, oi##X##0[i] << 16); O[2 * i + 1] = __builtin_bit_cast(float, oi##X##0[i] & 0xffff0000u); O[8 + 2 * i] = __builtin_bit_cast(float, oi##X##1[i] << 16); O[9 + 2 * i] = __builtin_bit_cast(float, oi##X##1[i] & 0xffff0000u); } \
        { const LAS unsigned char* fq_ = lds + S_QL + (c % 3) * 8192 + hi * 1024 + (32 * ib + r32) * 16; \
          const LAS unsigned char* sp = lds + S_ST + (c & 1) * 16384 + hi * 2048 + (32 * vb + r32) * 16; \
          _Pragma("unroll") for (int s_ = 0; s_ < 4; ++s_) O = __builtin_amdgcn_mfma_f32_32x32x16_bf16(*(const LAS bf16x8*)(fq_ + s_ * 2048), *(const LAS bf16x8*)(sp + s_ * 4096), O, 0, 0, 0); } \
        { LAS unsigned char* sw = lds + S_ST + ((c + 1) & 1) * 16384 + (32 * vb + r32) * 16 + 8 * hi; \
          LAS unsigned short* X_ = (LAS unsigned short*)(lds + S_X + (c & 1) * 16384); \
          _Pragma("unroll") for (int g = 0; g < 4; ++g) { const f32x4 dd_ = *(const LAS f32x4*)(lds + S_DEC + (c % 3) * 256 + (32 * ib + 8 * g + 4 * hi) * 4); \
              _Pragma("unroll") for (int i = 0; i < 4; ++i) { const int r = 4 * g + i; const unsigned uw_ = (r < 8 ? uu##X##0 : uu##X##1)[(r & 7) >> 1]; \
                  S[r] = S[r] * dd_[i] + ((r & 1) ? __builtin_bit_cast(float, uw_ & 0xffff0000u) : __builtin_bit_cast(float, uw_ << 16)); \
                  X_[(32 * ib + 8 * g + 4 * hi + i) * 128 + 32 * vb + r32] = (unsigned short)f2bf(O[r]); } \
              *(LAS v2u*)(sw + (4 * ib + g) * 2048) = (v2u){cvtpk_s(S[4 * g], S[4 * g + 1]), cvtpk_s(S[4 * g + 2], S[4 * g + 3])}; } } \
        pg0 = gg##X##0; pg1 = gg##X##1; }
#pragma unroll 1
    for (int c3 = 0; ; c3 += 3) { SQ_ITER(c3, A, C) SQ_ITER(c3 + 1, B, A) SQ_ITER(c3 + 2, C, B) }
sq_done_:
    asm volatile("s_waitcnt vmcnt(0) lgkmcnt(0)\n\ts_barrier" ::: "memory");
#undef SQ_ITER
#undef SQ_DECDMA
#undef SQ_QLDMA
#undef SQ_LOAD
}
}

struct Args { const float* in[30]; float* out; unsigned char* ws; int ph_lo, ph_hi; };
__global__ void __launch_bounds__(NWAVES * 64, 2) mega(Args args) {
    extern __shared__ __attribute__((aligned(16))) unsigned char lds_[];
    Frame F;
    F.lds = (LAS unsigned char*)lds_;
    volatile LAS unsigned* MISC = (volatile LAS unsigned*)(F.lds + MISC_OFF);
    refresh(F);
    F.G = gridDim.x; { const int bx = blockIdx.x; F.vcu = (F.G % 8 == 0) ? (bx % 8) * (F.G / 8) + bx / 8 : bx; }
    unsigned char* ws = args.ws;
    gu32* ctl = (gu32*)(ws + WS_CTL);
    for (int u = F.tid; u < (LDS_BYTES - MISC_OFF) / 4; u += NWAVES * 64) ((LAS unsigned*)(F.lds + MISC_OFF))[u] = 0u;
    __syncthreads();
    XcdBarrier bar = xcd_barrier_post((unsigned*)ctl + CW_BAR, MISC + 8);
    const int lo = args.ph_lo, hi = args.ph_hi;
#define IN(k) (lo <= (k) && (k) < hi)
#define BOTH(k) (IN(k) && IN((k) + 1))
    LAS float* xch = (LAS float*)(F.lds + XCH_OFF);
    LAS unsigned char* idxl = F.lds + IDX_OFF;
    if (IN(0)) { p0_prologue(F, args.in, ws); if (BOTH(0)) xcd_barrier(bar); }
    if (IN(1)) {
        EpiIn E{(bf16*)(ws + WS_RB), (bf16*)(ws + WS_RB) + (size_t)T * 512, (bf16*)(ws + WS_RB) + (size_t)T * 1024,
                (bf16*)(ws + WS_RC), (bf16*)(ws + WS_RC) + (size_t)T * 256, (bf16*)(ws + WS_RC) + (size_t)T * 512, (bf16*)(ws + WS_RC) + (size_t)T * 1024, args.in[4], args.in[5], (const float*)(ws + WS_SA), (const float*)(ws + WS_SB)};
        { OrderMN S; S.init(ws + WS_RA, 1024, ws + WS_WIN, 1024, T, 3072, F.G, (int)blockIdx.x);
          pg8::gemm_phase<EpiIn, OrderMN, false, true>(F.lds + RING_OFF, idxl, 1024, 1024, 512  , S, E); }
        if (BOTH(1)) xcd_barrier(bar);
    }
    if (IN(2)) {
        const bf16* DQ = (const bf16*)(ws + WS_RB); const bf16* DK = DQ + (size_t)T * 512; const bf16* DV = DQ + (size_t)T * 1024;
        const bf16* GQ = (const bf16*)(ws + WS_RC); const bf16* GK = GQ + (size_t)T * 256; const bf16* GV = GQ + (size_t)T * 512; const bf16* GG = GQ + (size_t)T * 1024;
        bf16* MIX = (bf16*)(ws + WS_RA);
        float lam; bool fastda;
        { int ln = threadIdx.x; asm volatile("" : "+v"(ln)); ln &= 63; const float a1 = wave_sum(args.in[6][ln] * args.in[7][ln]), a2 = wave_sum(args.in[8][ln] * args.in[9][ln]); lam = expf(a1) - expf(a2) + LAM_INIT;
          float gq = fabsf(args.in[4][ln]), gk = fabsf(args.in[5][ln]);
#pragma unroll
          for (int o = 1; o < 64; o <<= 1) { gq = fmaxf(gq, __shfl_xor(gq, o)); gk = fmaxf(gk, __shfl_xor(gk, o)); }
          fastda = __builtin_amdgcn_readfirstlane((int)(11.6f * gq * gk <= 32.f)) != 0; }
        unsigned char* QLG = ws + WS_RD; unsigned char* OIG = QLG + 16 * MiB; unsigned char* UG = OIG + 32 * MiB; float* DECG = (float*)(UG + 32 * MiB);
        gla2::prep_units(F.lds + RING_OFF, F.lds + XCH_OFF, (int)blockIdx.x, (int)F.G, 2048, GQ, GK, GV, (const float*)(ws + WS_GR), args.in[11], args.in[12], QLG, OIG, UG, DECG);
        xcd_barrier(bar);
        { OrderMN S; S.init(ws + WS_MN, 2048, ws + WS_WCKV, 2048, TM, 1024, F.G, (int)blockIdx.x - 64);
          EpiNorm256 E{(bf16*)(ws + WS_KC), 1024, args.in[20], nullptr, 1.f, xch};
          pg8::gemm_phase<EpiNorm256, OrderMN, false>(F.lds + RING_OFF, idxl, 2048, 2048, 1024, S, E); }
        { OrderMN S; S.init(ws + WS_WCKV + (size_t)1024 * 2048, 2048, ws + WS_MN, 2048, 1024, TM, F.G, (int)blockIdx.x - 128);
          EpiPlain E{(bf16*)(ws + WS_VCT), 2048};
          pg8::gemm_phase<EpiPlain, OrderMN, false>(F.lds + RING_OFF, idxl, 2048, 2048, 1024, S, E); }
        bool have_ticket = false;
        for (;;) {
            if (!have_ticket) { int t0_ = threadIdx.x; asm volatile("" : "+v"(t0_)); if (t0_ == 448) MISC[4] = __hip_atomic_fetch_add((unsigned*)ctl + CW_Q, 1u, __ATOMIC_RELAXED, __HIP_MEMORY_SCOPE_AGENT); }
            have_ticket = false;
            asm volatile("s_waitcnt lgkmcnt(0)\n\ts_barrier" ::: "memory");
            const int kq = __builtin_amdgcn_readfirstlane((int)MISC[4]);
            asm volatile("s_waitcnt lgkmcnt(0)\n\ts_barrier" ::: "memory");
            if (kq >= 32 + 1024 + 256) break;
            if (kq >= 32 + 1024) { Frame F2 = F; refresh(F2); const int j = kq - 1056; conv8_tiles(args.in, ws, (LAS float*)(F.lds + RING_OFF), xch, F2.tid, j < 128 ? 2 * j : 128 + j, j < 128 ? 2 : 1); continue; }
            if (kq < 32) gla2::seq_unit(F.lds + RING_OFF, kq, GG, args.in[13], QLG, OIG, UG, DECG, MIX);
            else { const int k2 = kq - 32, qb = 31 - (k2 >> 5), bh = k2 & 31; if (fastda) da2::unit<true>(F.lds + RING_OFF, xch, bh >> 2, bh & 3, qb, DQ, DK, DV, MIX, lam, args.in[10], (unsigned*)ctl + CW_Q, MISC + 4); else da2::unit<false>(F.lds + RING_OFF, xch, bh >> 2, bh & 3, qb, DQ, DK, DV, MIX, lam, args.in[10], (unsigned*)ctl + CW_Q, MISC + 4);
                   have_ticket = true; }
        }
        if (BOTH(2)) xcd_barrier(bar);
    }
    bf16* H1B = (bf16*)(ws + WS_RB);
    bf16* QC = (bf16*)(ws + WS_RC);
    bf16* PB = (bf16*)(ws + WS_RD);
    bf16* OC = (bf16*)(ws + WS_RA);
    bf16* H2B = (bf16*)(ws + WS_RC);
    bf16* HID = (bf16*)(ws + WS_RD);
    bf16* YB = (bf16*)(ws + WS_RA);
    if (IN(3)) {
        OrderMN S; S.init(ws + WS_RA, 2048, ws + WS_WO, 2048, T, 1024, F.G, (int)blockIdx.x);
        EpiRes<false, true> E{args.in[0], H1B, (float*)(ws + WS_SSQ1), xch};
        pg8::gemm_phase<EpiRes<false, true>, OrderMN, false>(F.lds + RING_OFF, idxl, 2048, 2048, 1024, S, E);
        if (BOTH(3)) xcd_barrier(bar);
    }
    if (IN(4)) {
        OrderPanel S{(const char*)H1B, (const char*)(ws + WS_WCQ), F.G, F.vcu  };
        EpiNorm256 E{QC, 1024, args.in[19], (const float*)(ws + WS_SSQ1), 0.0625f * LOG2E, xch};
        pg8::gemm_phase<EpiNorm256, OrderPanel, false>(F.lds + RING_OFF, idxl, 2048, 2048, 1024, S, E);
        if (BOTH(4)) { asm volatile("s_waitcnt vmcnt(0)" ::: "memory"); __syncthreads(); }
    }
    if (IN(5)) {
        { OrderCross S{(const char*)QC, (const char*)(ws + WS_KC), 2048, 256 * 2048, 512, F.G, F.vcu  };
          EpiSoftmax E{PB, (float*)(ws + WS_RSUM), xch};
          pg8::gemm_phase<EpiSoftmax, OrderCross, false>(F.lds + RING_OFF, idxl, 2048, 2048, 256, S, E); }
        asm volatile("s_waitcnt vmcnt(0)" ::: "memory"); __syncthreads();
        { OrderCross S{(const char*)PB, (const char*)(ws + WS_VCT), 4096, 512, 256 * 4096, F.G, F.vcu  };
          EpiPV E{OC, (const float*)(ws + WS_RSUM)};
          pg8::gemm_phase<EpiPV, OrderCross, false>(F.lds + RING_OFF, idxl, 2048, 4096, 256, S, E); }
        if (BOTH(5)) xcd_barrier(bar);
    }
    if (IN(6)) {
        OrderMN S; S.init(OC, 2048, ws + WS_WCO, 2048, T, 1024, F.G, (int)blockIdx.x);
        EpiRes<true, true> E{H1B, H2B, (float*)(ws + WS_SSQ2), xch};
        pg8::gemm_phase<EpiRes<true, true>, OrderMN, false>(F.lds + RING_OFF, idxl, 2048, 2048, 1024, S, E);
        if (BOTH(6)) xcd_barrier(bar);
    }
    if (IN(7)) {
        { Frame F2 = F; refresh(F2); const int bx = (int)blockIdx.x;
          quant_rows(H2B, ws + WS_RA, (const float*)(ws + WS_SSQ2), (float*)(ws + WS_RSTD), F2.lane, bx < 128 ? bx * 64 + F2.wave * 8 : 8192 + (bx - 128) * 192 + F2.wave * 24, bx < 128 ? 8 : 24); }
        OrderMN S; S.init(H2B, 2048, ws + WS_WR, 2048, T, 256, F.G, (int)blockIdx.x);
        EpiRouter E{(const float*)(ws + WS_SSQ2), args.in[24], args.in[26], (unsigned*)(ws + WS_CTL) + CW_CNT, (int*)(ws + WS_LIST), (float*)(ws + WS_GATE), (float*)(ws + WS_RSTD), (int*)(ws + WS_TOKPOS), xch};
        pg8::gemm_phase<EpiRouter, OrderMN, false>(F.lds + RING_OFF, idxl, 2048, 2048, 1024, S, E);
        if (blockIdx.x >= 128) { Frame F2 = F; refresh(F2); const int w_ = (int)blockIdx.x - 128;
            conv8_tiles(args.in, ws, (LAS float*)(F.lds + RING_OFF), xch, F2.tid, 384 + 5 * w_, 5);
            conv_tiles(args.in, ws, (LAS float*)(F.lds + RING_OFF), F2.tid, 2048 + 2 * w_, 2); }
        if (BOTH(7)) xcd_barrier(bar);
    }
    if (IN(8)) {
        moe_table(F, ws);
        OrderMoe S{(const LAS int*)(F.lds + TAB_OFF), 0, 32, (const char*)(ws + WS_RA)  , (const char*)(ws + WS_WGU), (size_t)1024 * 1024, 1024, 1024, (const int*)(ws + WS_LIST), F.G, F.vcu  , true};
        EpiGU E{HID, (const int*)(ws + WS_LIST), (const float*)(ws + WS_RSTD), (const float*)(ws + WS_SBGU)};
        pg8::gemm_phase<EpiGU, OrderMoe, true, true>(F.lds + RING_OFF, idxl, 1024, 1024, 512  , S, E);
        {
            const int nun = 4 * __builtin_amdgcn_readfirstlane(((const LAS int*)(F.lds + TAB_OFF))[32]), r = nun % F.G, n_idle = r ? F.G - r : 0;
            int first = 0, cnt = 0;
            if (n_idle >= 64) { if (F.vcu >= r) { const int per = (768 + n_idle - 1) / n_idle, idx = F.vcu - r; first = idx * per; cnt = 768 - first; cnt = cnt < 0 ? 0 : (cnt > per ? per : cnt); } }
            else { first = F.vcu * 3; cnt = 3; }
            Frame F2 = F; refresh(F2); __syncthreads();
            conv_tiles(args.in, ws, (LAS float*)(F.lds + RING_OFF), F2.tid, 2304 + first, cnt); }
        if (BOTH(8)) xcd_barrier(bar);
    }
    if (IN(9)) {
        moe_table(F, ws);
        OrderMoe S{(const LAS int*)(F.lds + TAB_OFF), 0, 32, (const char*)HID, (const char*)(ws + WS_WD), (size_t)1024 * 1024, 1024, 1024, (const int*)(ws + WS_LIST), F.G, F.vcu  , false};
        EpiY E{YB, (const float*)(ws + WS_GATE)};
        pg8::gemm_phase<EpiY, OrderMoe, false>(F.lds + RING_OFF, idxl, 1024, 1024, 512, S, E);
        if (BOTH(9)) xcd_barrier(bar);
    }
    if (IN(10)) { moe_table(F, ws); p10_combine(F, H2B, YB, args.out, ws); }
#undef IN
#undef BOTH
}

extern "C" void kernel_launch(void* const* d_in, const int* in_sizes, int n_in, void* d_out, int out_size, void* d_ws, size_t ws_size, hipStream_t stream) {
    static int grid = 0;
    if (grid == 0) {
        if (n_in != 30 || out_size != T * D || ws_size < 512 * MiB) { fprintf(stderr, "kernel_launch: unexpected shapes (n_in %d out %d ws %zu)\n", n_in, out_size, ws_size); grid = -1; return; }
        int dev = 0, cus = 0, per_cu = 0;
        if (hipGetDevice(&dev) != hipSuccess || hipDeviceGetAttribute(&cus, hipDeviceAttributeMultiprocessorCount, dev) != hipSuccess) { grid = -1; return; }
        if (hipFuncSetAttribute((const void*)mega, hipFuncAttributeMaxDynamicSharedMemorySize, LDS_BYTES) != hipSuccess) { grid = -1; return; }
        if (hipOccupancyMaxActiveBlocksPerMultiprocessor(&per_cu, (const void*)mega, NWAVES * 64, LDS_BYTES) != hipSuccess || per_cu < 1) { fprintf(stderr, "kernel_launch: occupancy query says %d\n", per_cu); }
        (void)hipGetLastError();
        if (cus != 256) { fprintf(stderr, "kernel_launch: built for a 256-CU device (got %d); nothing launched\n", cus); grid = -1; return; }
        grid = cus;
    }
    if (grid < 0) return;
    (void)hipMemsetAsync((char*)d_ws + WS_CTL, 0, CTL_ZERO_BYTES, stream);
    Args a; memset(&a, 0, sizeof(a));
    for (int i = 0; i < 30; ++i) a.in[i] = (const float*)d_in[i];
    a.out = (float*)d_out; a.ws = (unsigned char*)d_ws; a.ph_lo = 0; a.ph_hi = 11;
    hipLaunchKernelGGL(mega, dim3(grid), dim3(NWAVES * 64), LDS_BYTES, stream, a);
}
```

```cpp
#include <hip/hip_runtime.h>
#include <cstdio>
#include <cstdint>
#include <cstring>
#include <cmath>
#ifndef PROBE
#define PROBE -1
#endif

#define GAS __attribute__((address_space(1)))
#define LAS __attribute__((address_space(3)))
#define WTAB_LDS_OFF (131072 + 4096 + 1024 + 2048 + 512)
__device__ __forceinline__ int my_tid() {
    const unsigned hw = (unsigned)__builtin_amdgcn_s_getreg((5 << 11) | 4) & 63u;
    const int w = __builtin_amdgcn_readfirstlane(*(volatile LAS int*)(unsigned long)(WTAB_LDS_OFF + 4u * hw));
    int l; asm volatile("v_mbcnt_lo_u32_b32 %0, -1, 0\n\tv_mbcnt_hi_u32_b32 %0, -1, %0" : "=v"(l));
    return w * 64 + l;
}
typedef unsigned short bf16;
typedef unsigned v4u __attribute__((ext_vector_type(4)));
typedef unsigned v2u __attribute__((ext_vector_type(2)));
typedef float f32x4 __attribute__((ext_vector_type(4)));
typedef float f32x16 __attribute__((ext_vector_type(16)));
typedef short bf16x8 __attribute__((ext_vector_type(8)));
typedef int i32x4 __attribute__((ext_vector_type(4)));
typedef int i32x8 __attribute__((ext_vector_type(8)));
typedef GAS unsigned gu32;
#define RLX_AGENT __ATOMIC_RELAXED, __HIP_MEMORY_SCOPE_AGENT
#define LDS_WAIT() asm volatile("s_waitcnt lgkmcnt(0)" ::: "memory")
#define VM_WAIT() asm volatile("s_waitcnt vmcnt(0)" ::: "memory")
__device__ __forceinline__ unsigned f2bf(float f) { unsigned u = __builtin_bit_cast(unsigned, f); return (u + 0x7fffu + ((u >> 16) & 1u)) >> 16; }
__device__ __forceinline__ unsigned pk2(float lo, float hi) { return f2bf(lo) | (f2bf(hi) << 16); }
__device__ __forceinline__ float bf2f(unsigned short b) { return __builtin_bit_cast(float, ((unsigned)b) << 16); }
typedef float f32x2_t __attribute__((ext_vector_type(2))); typedef __bf16 bf16x2_t __attribute__((ext_vector_type(2)));
__device__ __forceinline__ unsigned cvtpk_s(float lo, float hi) { f32x2_t v = {lo, hi}; bf16x2_t b = __builtin_convertvector(v, bf16x2_t); return __builtin_bit_cast(unsigned, b); }
__device__ __forceinline__ unsigned cvt_pk_bf16(float lo, float hi) { return cvtpk_s(lo, hi); }
__device__ __forceinline__ unsigned pk_fp8x4(float a, float b, float c, float d) {
    a = __builtin_fminf(__builtin_fmaxf(a, -448.f), 448.f); b = __builtin_fminf(__builtin_fmaxf(b, -448.f), 448.f); c = __builtin_fminf(__builtin_fmaxf(c, -448.f), 448.f); d = __builtin_fminf(__builtin_fmaxf(d, -448.f), 448.f);
    int r = __builtin_amdgcn_cvt_pk_fp8_f32(a, b, 0, false); r = __builtin_amdgcn_cvt_pk_fp8_f32(c, d, r, true); return (unsigned)r; }

namespace pg8 {
constexpr int BM = 256, BK = 64, HALF = 128, HTB = HALF * BK * 2, STAGE_BYTES = 8 * HTB;
__host__ __device__ __forceinline__ int lds_byte(int r, int c) { const int st = (r >> 4) * 2 + (c >> 5), rr = r & 15, cc = c & 31, ob = rr * 64 + cc * 2; return st * 1024 + (ob ^ (((ob >> 9) & 1) << 5)); }
__host__ __device__ __forceinline__ void stage_rc(int b, int& R, int& C) { const int st = b / 1024, sb = b % 1024, swz = sb ^ (((sb >> 9) & 1) << 5); R = (st >> 1) * 16 + swz / 64; C = (st & 1) * 32 + (swz % 64) / 2; }
__host__ __device__ __forceinline__ int perm32(int rho) { const int n = rho >> 4, i = rho & 15; return 8 * (i >> 2) + 4 * n + (i & 3); }

template <class E, class = void> struct epi_pre { static constexpr bool has = false; };
template <class E> struct epi_pre<E, decltype((void)sizeof(typename E::Pre))> { static constexpr bool has = true; };
template <class Epi, class Sched, bool GATHER, bool I8 = false, bool F8 = false>
__device__ __forceinline__ void gemm_phase(LAS unsigned char* lds, LAS unsigned char* idxlds  , const int lda, const int ldb, const int K, const Sched& S, const Epi& E, const unsigned char* wsb  ) {
    int tid_ = my_tid(); asm volatile("" : "+v"(tid_));
    const int tid = tid_, wid = __builtin_amdgcn_readfirstlane(tid >> 6), lane = tid & 63, wr = wid >> 2, wc = wid & 3, fr = lane & 15, fq = lane >> 4;
    const int nt = K / BK;
    const __amdgpu_buffer_rsrc_t rs_ = __builtin_amdgcn_make_buffer_rsrc((void*)wsb, 0, 0xffffffff, 0x00020000);
    int Rr[2], Cb[2]; unsigned voffB[2];
#pragma unroll
    for (int i = 0; i < 2; ++i) { int R, C; stage_rc(tid * 16 + i * 8192, R, C); const int Rb = Epi::PERM ? ((R & ~31) + perm32(R & 31)) : R; Rr[i] = R; Cb[i] = C * 2; voffB[i] = (unsigned)(Rb * ldb + C * 2); }
    const size_t kstep = (size_t)(BK * 2);
    const size_t hstepB = (size_t)HALF * ldb, hstepA = (size_t)HALF * lda;
    const unsigned ldsw = (unsigned)wid * 1024u;
    const int aoff = lds_byte(wr * 64 + fr, fq * 8), boff = lds_byte(wc * 32 + fr, fq * 8);
    LAS unsigned char* ldsB = lds + 4 * HTB + boff; asm volatile("" : "+v"(ldsB));
#define PG8_SA(b, h) (((b) * 2 + (h)) * HTB)
#define PG8_SB(b, h) ((4 + (b) * 2 + (h)) * HTB)
#define PG8_STG_B(bufoff, gbase, h) do { const unsigned so_ = (unsigned)((const unsigned char*)(gbase) - wsb) + (unsigned)(h) * (unsigned)hstepB; _Pragma("unroll") for (int _i = 0; _i < 2; ++_i) \
        __builtin_amdgcn_raw_ptr_buffer_load_lds(rs_, (LAS void*)(lds + (bufoff) + ldsw + _i * 8192), 16, voffB[0], so_ + (unsigned)_i * 64u * (unsigned)ldb, 0, 0); } while (0)
#define PG8_STG_A(bufoff, gbase, h, OA) do { const unsigned so_ = (unsigned)((const unsigned char*)(gbase) - wsb) + (GATHER ? 0u : (unsigned)(h) * (unsigned)hstepA); _Pragma("unroll") for (int _i = 0; _i < 2; ++_i) \
        __builtin_amdgcn_raw_ptr_buffer_load_lds(rs_, (LAS void*)(lds + (bufoff) + ldsw + _i * 8192), 16, (OA)[GATHER ? (h) : 0][GATHER ? _i : 0], so_ + (GATHER ? 0u : (unsigned)_i * 64u * (unsigned)lda), 0, 0); } while (0)
#define PG8_LDA(dst, b, h) do { if constexpr (F8) { _Pragma("unroll") for (int m = 0; m < 4; ++m) { dst##8[m].lo = *(const LAS i32x4*)(lds + PG8_SA(b, h) + aoff + m * 2048); dst##8[m].hi = *(const LAS i32x4*)(lds + PG8_SA(b, h) + aoff + m * 2048 + 1024); } } \
        else { _Pragma("unroll") for (int m = 0; m < 4; ++m) _Pragma("unroll") for (int k = 0; k < 2; ++k) dst[m][k] = *(const LAS bf16x8*)(lds + PG8_SA(b, h) + aoff + m * 2048 + k * 1024); } } while (0)
#define PG8_LDB(dst, b, h) do { if constexpr (F8) { _Pragma("unroll") for (int n = 0; n < 2; ++n) { dst##8[n].lo = *(const LAS i32x4*)(ldsB + (PG8_SB(b, h) - 4 * HTB) + n * 2048); dst##8[n].hi = *(const LAS i32x4*)(ldsB + (PG8_SB(b, h) - 4 * HTB) + n * 2048 + 1024); } } \
        else { _Pragma("unroll") for (int n = 0; n < 2; ++n) _Pragma("unroll") for (int k = 0; k < 2; ++k) dst[n][k] = *(const LAS bf16x8*)(ldsB + (PG8_SB(b, h) - 4 * HTB) + n * 2048 + k * 1024); } } while (0)
#define PG8_MMA(ai, bj, At, Bt) do { __builtin_amdgcn_s_setprio(1); \
        if constexpr (F8) { _Pragma("unroll") for (int m = 0; m < 4; ++m) _Pragma("unroll") for (int n = 0; n < 2; ++n) \
            acc[ai][bj][m][n] = __builtin_amdgcn_mfma_scale_f32_16x16x128_f8f6f4(Bt##8[n], At##8[m], acc[ai][bj][m][n], 0, 0, 0, 0x7f7f7f7f, 0, 0x7f7f7f7f); }     \
        else { _Pragma("unroll") for (int m = 0; m < 4; ++m) _Pragma("unroll") for (int n = 0; n < 2; ++n) _Pragma("unroll") for (int k = 0; k < 2; ++k) \
        { if constexpr (I8) acc[ai][bj][m][n] = __builtin_bit_cast(f32x4, __builtin_amdgcn_mfma_i32_16x16x64_i8(__builtin_bit_cast(i32x4, Bt[n][k]), __builtin_bit_cast(i32x4, At[m][k]), __builtin_bit_cast(i32x4, acc[ai][bj][m][n]), 0, 0, 0)); \
          else acc[ai][bj][m][n] = __builtin_amdgcn_mfma_f32_16x16x32_bf16(Bt[n][k], At[m][k], acc[ai][bj][m][n], 0, 0, 0); } } __builtin_amdgcn_s_setprio(0); } while (0)
#define PG8_WAIT_V(n) asm volatile("s_waitcnt vmcnt(" #n ")" ::: "memory")
#define PG8_WAIT_L(n) asm volatile("s_waitcnt lgkmcnt(" #n ")" ::: "memory")
#define PG8_BAR __builtin_amdgcn_s_barrier()
#define PG8_SCHED __builtin_amdgcn_sched_barrier(0)
    typename Sched::Unit cur, nxt; int ui = 0;
    if (!S.next(0, cur)) return;
    f32x4 acc[2][2][4][2];
#pragma unroll
    for (int a = 0; a < 2; ++a)
#pragma unroll
        for (int b = 0; b < 2; ++b)
#pragma unroll
            for (int m = 0; m < 4; ++m)
#pragma unroll
                for (int n = 0; n < 2; ++n) acc[a][b][m][n] = (f32x4){0.f, 0.f, 0.f, 0.f};
    bf16x8 At[4][2], B0[2][2], B1[2][2]; i32x8 At8[4], B08[2], B18[2];
    unsigned offA[2][2];
    if constexpr (GATHER) { const int* ix = S.idx(cur);
#pragma unroll
        for (int h = 0; h < 2; ++h)
#pragma unroll
            for (int i = 0; i < 2; ++i) offA[h][i] = (unsigned)ix[Rr[0] + 64 * i + HALF * h] * (unsigned)lda + (unsigned)Cb[0];
    } else {
#pragma unroll
        for (int h = 0; h < 2; ++h)
#pragma unroll
            for (int i = 0; i < 2; ++i) offA[h][i] = (unsigned)Rr[i] * (unsigned)lda + (unsigned)Cb[i];
    }
    const char* cA = S.pa(cur); const char* cB = S.pb(cur);
    if constexpr (epi_pre<Epi>::has) { int t_p = my_tid(); asm volatile("" : "+v"(t_p)); E.prefetch(cur, wr, wid, t_p & 63, (const LAS int*)nullptr); }
    PG8_STG_B(PG8_SB(0, 0), cB, 0); PG8_STG_B(PG8_SB(0, 1), cB, 1); PG8_STG_A(PG8_SA(0, 0), cA, 0, offA); PG8_STG_A(PG8_SA(0, 1), cA, 1, offA);
    if (wr == 1) PG8_BAR;
    PG8_WAIT_V(2); PG8_BAR;
    PG8_STG_B(PG8_SB(1, 0), cB + kstep, 0); PG8_STG_A(PG8_SA(1, 0), cA + kstep, 0, offA); PG8_STG_B(PG8_SB(1, 1), cB + kstep, 1);
    PG8_WAIT_V(6); PG8_BAR;
    for (;;) {
        const bool has_next = S.next(ui + 1, nxt);
        const char* nA = has_next ? S.pa(nxt) : cA; const char* nB = has_next ? S.pb(nxt) : cB;
        if constexpr (GATHER) { if (has_next && wid == 0) {
            int t_i = my_tid(); asm volatile("" : "+v"(t_i));
            __builtin_amdgcn_raw_ptr_buffer_load_lds(rs_, (LAS void*)(idxlds + ((ui + 1) & 1) * 1024), 16, (t_i & 63) * 16, (unsigned)((const unsigned char*)S.idx(nxt) - wsb), 0, 0); } }
#pragma unroll 1
        for (int t = 0; t < nt; t += 2) {
            const bool last = (t == nt - 2);
            const char* a1 = cA + (size_t)(t + 1) * kstep;
            const char* a2 = last ? nA : cA + (size_t)(t + 2) * kstep; const char* b2 = last ? nB : cB + (size_t)(t + 2) * kstep;
            const char* a3 = a2 + kstep; const char* b3 = b2 + kstep;
            unsigned o2s[2][2];
            const unsigned (&o2)[2][2] = *(GATHER ? &o2s : &offA);
            if constexpr (GATHER) {
                if (last && has_next) { const LAS int* ix = (const LAS int*)(idxlds + ((ui + 1) & 1) * 1024); int t_r = my_tid(); asm volatile("" : "+v"(t_r)); int R_, C_; stage_rc((t_r & 511) * 16, R_, C_);
#pragma unroll
                    for (int h = 0; h < 2; ++h)
#pragma unroll
                        for (int i = 0; i < 2; ++i) o2s[h][i] = (unsigned)ix[R_ + 64 * i + HALF * h] * (unsigned)lda + (unsigned)(2 * C_); }
                else {
#pragma unroll
                    for (int h = 0; h < 2; ++h)
#pragma unroll
                        for (int i = 0; i < 2; ++i) o2s[h][i] = offA[h][i]; }
            }
            PG8_LDB(B0, 0, 0); PG8_LDB(B1, 0, 1); PG8_SCHED; PG8_LDA(At, 0, 0); PG8_STG_A(PG8_SA(1, 1), a1, 1, offA);
            PG8_WAIT_V(8); PG8_WAIT_L(0); PG8_BAR; PG8_MMA(0, 0, At, B0); PG8_MMA(0, 1, At, B1); PG8_BAR; PG8_SCHED;
            PG8_LDA(At, 0, 1); PG8_STG_B(PG8_SB(0, 0), b2, 0); PG8_STG_B(PG8_SB(0, 1), b2, 1); PG8_STG_A(PG8_SA(0, 0), a2, 0, o2);
            PG8_WAIT_V(8); PG8_WAIT_L(0); PG8_BAR; PG8_MMA(1, 0, At, B0); PG8_MMA(1, 1, At, B1); PG8_BAR; PG8_SCHED;
            PG8_LDB(B0, 1, 0); PG8_LDB(B1, 1, 1); PG8_SCHED; PG8_LDA(At, 1, 0); PG8_STG_A(PG8_SA(0, 1), a2, 1, o2);
            PG8_WAIT_V(8); PG8_WAIT_L(0); PG8_BAR; PG8_MMA(0, 0, At, B0); PG8_MMA(0, 1, At, B1); PG8_BAR; PG8_SCHED;
            PG8_LDA(At, 1, 1); PG8_STG_B(PG8_SB(1, 0), b3, 0); PG8_STG_B(PG8_SB(1, 1), b3, 1); PG8_STG_A(PG8_SA(1, 0), a3, 0, o2);
            PG8_WAIT_V(8); PG8_WAIT_L(0); PG8_BAR; PG8_MMA(1, 0, At, B0); PG8_MMA(1, 1, At, B1); PG8_BAR; PG8_SCHED;
        }
        if (wr == 0) PG8_BAR;
        { int t_e = my_tid(); asm volatile("" : "+v"(t_e));
          E(acc, cur, wr, wc, t_e & 15, (t_e & 63) >> 4); }
        if (!has_next) break;
        if constexpr (epi_pre<Epi>::has) { int t_p = my_tid(); asm volatile("" : "+v"(t_p)); E.prefetch(nxt, wr, wid, t_p & 63, GATHER ? (const LAS int*)(idxlds + ((ui + 1) & 1) * 1024) : (const LAS int*)nullptr); }
#pragma unroll
        for (int a = 0; a < 2; ++a)
#pragma unroll
            for (int b = 0; b < 2; ++b)
#pragma unroll
                for (int m = 0; m < 4; ++m)
#pragma unroll
                    for (int n = 0; n < 2; ++n) acc[a][b][m][n] = (f32x4){0.f, 0.f, 0.f, 0.f};
        if constexpr (GATHER) { const LAS int* ix = (const LAS int*)(idxlds + ((ui + 1) & 1) * 1024); int t_r = my_tid(); asm volatile("" : "+v"(t_r)); int R_, C_; stage_rc((t_r & 511) * 16, R_, C_);
#pragma unroll
        for (int h = 0; h < 2; ++h)
#pragma unroll
            for (int i = 0; i < 2; ++i) offA[h][i] = (unsigned)ix[R_ + 64 * i + HALF * h] * (unsigned)lda + (unsigned)(2 * C_); }
        cur = nxt; cA = nA; cB = nB; ++ui;
        if (wr == 1) PG8_BAR;
    }
    PG8_WAIT_V(0);
    PG8_BAR;
#undef PG8_SA
#undef PG8_SB
#undef PG8_STG_A
#undef PG8_STG_B
#undef PG8_LDA
#undef PG8_LDB
#undef PG8_MMA
#undef PG8_WAIT_V
#undef PG8_WAIT_L
#undef PG8_BAR
#undef PG8_SCHED
}
}

#define XB_TMO      128
#define XB_XCNT(j)  (256  + 64 * (j))
#define XB_XSUB(j)  (1280 + 64 * (j))
#define XB_XGEN(j)  (2304 + 64 * (j))
#define XB_TOP      3328
#define XB_TOPGEN   3392
#define XCD_BAR_WORDS 3456
#define XB_SPIN_CAP (1u << 22)

__device__ __forceinline__ unsigned xb_ld(unsigned* p)              { return __hip_atomic_load(p, __ATOMIC_RELAXED, __HIP_MEMORY_SCOPE_AGENT); }
__device__ __forceinline__ unsigned xb_add(unsigned* p, unsigned v) { return __hip_atomic_fetch_add(p, v, __ATOMIC_RELAXED, __HIP_MEMORY_SCOPE_AGENT); }
__device__ __forceinline__ unsigned xb_xcc_id() { return (unsigned)__builtin_amdgcn_s_getreg((3 << 11) | 20) & 0xFu; }
#define XB_SPIN(cond, bar) do { unsigned _sp = 0; while (cond) { __builtin_amdgcn_s_sleep(1); \
    if ((++_sp & 255u) == 0u) { if (xb_ld(&(bar)[XB_TMO])) break; if (_sp > XB_SPIN_CAP) { atomicAdd(&(bar)[XB_TMO], 1u); break; } } } } while (0)

struct XcdBarrier {
    unsigned* bar; unsigned x;
    volatile LAS unsigned* st;
};

__device__ __forceinline__ XcdBarrier xcd_barrier_post(unsigned* bar, volatile LAS unsigned* st) {
    XcdBarrier b; b.bar = bar; b.x = xb_xcc_id(); b.st = st;
    if (my_tid() == 0) (void)xb_add(&bar[XB_XCNT(b.x)], 1u);
    return b;
}
__device__ __forceinline__ void xcd_barrier_complete(unsigned* bar, unsigned x, unsigned& nloc, unsigned& nx) {
    const unsigned G = gridDim.x * gridDim.y * gridDim.z;
    unsigned sum, cnt, mine, sp = 0u;
    for (;;) {
        sum = 0u; cnt = 0u; mine = 0u;
#pragma unroll
        for (unsigned j = 0; j < 16; ++j) { const unsigned c = xb_ld(&bar[XB_XCNT(j)]); sum += c; cnt += (c > 0u) ? 1u : 0u; mine = (j == x) ? c : mine; }
        if (sum == G) break;
        __builtin_amdgcn_s_sleep(1);
        if ((++sp & 255u) == 0u) { if (xb_ld(&bar[XB_TMO])) break; if (sp > XB_SPIN_CAP) { atomicAdd(&bar[XB_TMO], 1u); break; } }
    }
    nloc = mine > 0u ? mine : 1u; nx = cnt > 0u ? cnt : 1u;
}

__device__ __forceinline__ void xcd_barrier(const XcdBarrier& b) {
    asm volatile("s_waitcnt vmcnt(0)" ::: "memory");
    __syncthreads();
    if (my_tid() == 0) {
        unsigned* bar = b.bar;
        __builtin_amdgcn_s_waitcnt(0);
        unsigned nloc = b.st[0], nx = b.st[1];
        if (nloc == 0u) { xcd_barrier_complete(bar, b.x, nloc, nx); b.st[0] = nloc; b.st[1] = nx; }
        const unsigned old = xb_add(&bar[XB_XSUB(b.x)], 1u);
        const unsigned gen = old / nloc;
        if (old + 1u == (gen + 1u) * nloc) {
            __builtin_amdgcn_fence(__ATOMIC_RELEASE, "agent");
            asm volatile("s_waitcnt vmcnt(0)" ::: "memory");
            const unsigned og = xb_add(&bar[XB_TOP], 1u);
            const unsigned tg = og / nx;
            if (og + 1u == (tg + 1u) * nx) xb_add(&bar[XB_TOPGEN], 1u);
            else XB_SPIN(xb_ld(&bar[XB_TOPGEN]) == tg, bar);
            __builtin_amdgcn_fence(__ATOMIC_ACQUIRE, "agent");
            xb_add(&bar[XB_XGEN(b.x)], 1u);
            asm volatile("s_waitcnt vmcnt(0)" ::: "memory");
        } else {
            XB_SPIN(xb_ld(&bar[XB_XGEN(b.x)]) == gen, bar);
            __builtin_amdgcn_fence(__ATOMIC_ACQUIRE, "agent");
            asm volatile("s_waitcnt vmcnt(0)" ::: "memory");
        }
    }
    __syncthreads();
}

constexpr int NWAVES = 8;
constexpr int NB = 8, SEQ = 4096, D = 1024, T = NB * SEQ, MEML = 256, TM = NB * MEML, INW = 3088;
constexpr float EPS = 1e-6f;
constexpr float LOG2E = 1.4426950408889634f;
constexpr float QSCALE = 0.125f * LOG2E;
constexpr float LAM_INIT = 0.2f;
constexpr size_t MiB = 1u << 20;
constexpr size_t WS_CTL = 0, CTL_ZERO_BYTES = 64 * 1024;
constexpr size_t WS_WIN = 1 * MiB;
constexpr size_t WS_WO = WS_WIN + 6 * MiB;
constexpr size_t WS_WCQ = WS_WO + 2 * MiB;
constexpr size_t WS_WCKV = WS_WCQ + 2 * MiB;
constexpr size_t WS_WCO = WS_WCKV + 4 * MiB;
constexpr size_t WS_WGU = WS_WCO + 2 * MiB;
constexpr size_t WS_WD = WS_WGU + 64 * MiB;
constexpr size_t WS_MN = WS_WD + 32 * MiB;
constexpr size_t WS_KC = WS_MN + 4 * MiB;
constexpr size_t WS_VCT = WS_KC + 4 * MiB;
constexpr size_t WS_GR = WS_VCT + 4 * MiB;
constexpr size_t WS_RA = WS_GR + 2 * MiB;
constexpr size_t WS_RB = WS_RA + 64 * MiB;
constexpr size_t WS_RC = WS_RB + 96 * MiB;
constexpr size_t WS_RD = WS_RC + 96 * MiB;
constexpr size_t WS_LIST = WS_RD + 96 * MiB;
constexpr size_t WS_GATE = WS_LIST + 8 * MiB;
constexpr size_t WS_RSTD = WS_GATE + 8 * MiB;
constexpr size_t WS_RSUM = WS_RSTD + 1 * MiB;
constexpr size_t WS_SSQ1 = WS_RSUM + 2 * MiB;
constexpr size_t WS_SSQ2 = WS_SSQ1 + 1 * MiB;
constexpr size_t WS_TOKPOS = WS_SSQ2 + 1 * MiB;
constexpr size_t WS_WR = WS_TOKPOS + 1 * MiB;
constexpr size_t WS_SA = WS_WR + 1 * MiB;
constexpr size_t WS_SB = WS_SA + 512 * 1024;
constexpr size_t WS_SBO = WS_SA + 600 * 1024;
constexpr float MIX_RDA = 6.35f, MIX_RGL = 6.35f;
constexpr size_t WS_SBGU = WS_SA + 640 * 1024;
constexpr size_t WS_END = WS_SA + 1 * MiB;
static_assert(WS_END <= 512 * MiB, "workspace");
constexpr int CAP = 32768;
constexpr int CW_Q = 2048;
constexpr int CW_CNT = 8192;
constexpr int CW_BAR = 4096;
static_assert((size_t)(CW_CNT + 64 * 64) * 4 <= CTL_ZERO_BYTES && (size_t)(CW_BAR + XCD_BAR_WORDS) * 4 <= (size_t)CW_CNT * 4 && CW_Q < CW_BAR, "control words must lie inside the zeroed region");
constexpr int RING_OFF = 0, RING_BYTES = 131072;
constexpr int XCH_OFF = RING_BYTES;
constexpr int TAB_OFF = XCH_OFF + 4096;
constexpr int IDX_OFF = TAB_OFF + 1024;
constexpr int MISC_OFF = IDX_OFF + 2048;
constexpr int LDS_BYTES = 147456;
static_assert(MISC_OFF + 256 <= LDS_BYTES, "LDS map");

struct Frame {
    LAS unsigned char* lds;
    int tid, lane, wave, vcu, G;
};
#define WV_DPP(v, ctrl) __builtin_bit_cast(float, __builtin_amdgcn_update_dpp(0, __builtin_bit_cast(int, (v)), (ctrl), 0xf, 0xf, false))
__device__ __forceinline__ float wave_sum(float v) {
    v += WV_DPP(v, 0xB1); v += WV_DPP(v, 0x4E); v += WV_DPP(v, 0x141); v += WV_DPP(v, 0x140);
    v += __shfl_xor(v, 16); v += __shfl_xor(v, 32);
    return v;
}
__device__ __forceinline__ float wave_max(float v) {
    v = fmaxf(v, WV_DPP(v, 0xB1)); v = fmaxf(v, WV_DPP(v, 0x4E)); v = fmaxf(v, WV_DPP(v, 0x141)); v = fmaxf(v, WV_DPP(v, 0x140));
    v = fmaxf(v, __shfl_xor(v, 16)); v = fmaxf(v, __shfl_xor(v, 32));
    return v;
}
template <class RM> __device__ __forceinline__ void tr_item(const float* __restrict__ W, int ldw, int c0, int K, int ncols, bf16* WT, const float* __restrict__ gain, RM rm, LAS float* scr, int item, int lane) {
    const int nblk = ncols / 32, kb = item / nblk, nb = item % nblk, k0 = 64 * kb, n0 = 32 * nb;
    const int r = lane >> 3, c4 = lane & 7;
    f32x4 w[8];
#pragma unroll
    for (int i = 0; i < 8; ++i) w[i] = *(const GAS f32x4*)(W + (size_t)(k0 + 8 * i + r) * ldw + c0 + n0 + 4 * c4);
#pragma unroll
    for (int i = 0; i < 8; ++i) { const int k = 8 * i + r; f32x4 v = w[i]; if (gain) v = v * gain[k0 + k]; *(LAS f32x4*)(scr + k * 36 + (k >> 5) * 32 + 4 * c4) = v; }
    LDS_WAIT(); asm volatile("" ::: "memory");
    const int n = lane & 31, kh = lane >> 5; const LAS float* s = scr + (32 * kh) * 36 + kh * 32 + n;
    unsigned pk[16];
#pragma unroll
    for (int j = 0; j < 16; ++j) pk[j] = pk2(s[(2 * j) * 36], s[(2 * j + 1) * 36]);
    GAS v4u* dst = (GAS v4u*)(WT + (size_t)rm(n0 + n) * K + k0 + 32 * kh);
#pragma unroll
    for (int j = 0; j < 4; ++j) dst[j] = (v4u){pk[4 * j], pk[4 * j + 1], pk[4 * j + 2], pk[4 * j + 3]};
    LDS_WAIT(); asm volatile("" ::: "memory");
}
struct TrDesc { const float* W; const float* gain; bf16* WT; int ldw, K, nblk, kind, base, r; };
__device__ __forceinline__ void tr_load(const TrDesc& d, int lane, f32x4 (&w)[8], float (&gk)[8]) {
    const int kb = d.r / d.nblk, nb = d.r % d.nblk, k0 = 64 * kb, n0 = 32 * nb, r = lane >> 3, c4 = lane & 7;
#pragma unroll
    for (int i = 0; i < 8; ++i) { w[i] = *(const GAS f32x4*)(d.W + (size_t)(k0 + 8 * i + r) * d.ldw + n0 + 4 * c4); gk[i] = d.gain ? d.gain[k0 + 8 * i + r] : 1.f; }
}
__device__ __forceinline__ void tr_finish(const TrDesc& d, int lane, const f32x4 (&w)[8], const float (&gk)[8], LAS float* scr) {
    const int kb = d.r / d.nblk, nb = d.r % d.nblk, k0 = 64 * kb, n0 = 32 * nb, r = lane >> 3, c4 = lane & 7;
#pragma unroll
    for (int i = 0; i < 8; ++i) { const int k = 8 * i + r; *(LAS f32x4*)(scr + k * 36 + (k >> 5) * 32 + 4 * c4) = w[i] * gk[i]; }
    LDS_WAIT(); asm volatile("" ::: "memory");
    const int n = lane & 31, kh = lane >> 5; const LAS float* sp = scr + (32 * kh) * 36 + kh * 32 + n;
    unsigned pk[16];
#pragma unroll
    for (int j = 0; j < 16; ++j) pk[j] = cvtpk_s(sp[(2 * j) * 36], sp[(2 * j + 1) * 36]);
    const int nn = n0 + n; int row;
    if (d.kind == 5) { LDS_WAIT(); asm volatile("" ::: "memory"); return; }
    if (d.kind == 3) {
        GAS v4u* d8 = (GAS v4u*)((GAS unsigned char*)d.WT + (size_t)(d.base + nn) * d.K + k0 + 32 * kh);
#pragma unroll
        for (int j = 0; j < 2; ++j) { v4u o;
#pragma unroll
            for (int q = 0; q < 4; ++q) { const int k = 16 * j + 4 * q; o[q] = pk_fp8x4(sp[k * 36] * 16.f, sp[(k + 1) * 36] * 16.f, sp[(k + 2) * 36] * 16.f, sp[(k + 3) * 36] * 16.f); }
            d8[j] = o; }
        LDS_WAIT(); asm volatile("" ::: "memory");
        return; }
    if (d.kind == 0) row = d.base + nn;
    else if (d.kind == 1) { if (nn >= 1024) row = nn; else { const int c = nn & 255, wc = c >> 6, bj = (c >> 5) & 1, j = c & 31; row = (nn & ~255) + 128 * bj + 32 * wc + j; } }
    else row = d.base + (nn >> 7) * 256 + (nn & 127);
    GAS v4u* dst = (GAS v4u*)(d.WT + (size_t)row * d.K + k0 + 32 * kh);
#pragma unroll
    for (int j = 0; j < 4; ++j) dst[j] = (v4u){pk[4 * j], pk[4 * j + 1], pk[4 * j + 2], pk[4 * j + 3]};
    LDS_WAIT(); asm volatile("" ::: "memory");
}
struct RmPlain { int off; __device__ __forceinline__ int operator()(int n) const { return off + n; } };
struct RmIn { __device__ __forceinline__ int operator()(int n) const { if (n >= 1024) return n; const int c = n & 255, wc = c >> 6, bj = (c >> 5) & 1, j = c & 31; return (n & ~255) + 128 * bj + 32 * wc + j; } };
struct RmGU { int base; __device__ __forceinline__ int operator()(int n) const { return base + (n >> 7) * 256 + (n & 127); } };

constexpr int TR_I_IN = 16 * 96, TR_I_SQ = 16 * 32, TR_I_CKV = 16 * 64, TR_I_E = 16 * 16, TR_I_D = 8 * 32;
constexpr int TR_NONEXPERT = TR_I_IN + 3 * TR_I_SQ + TR_I_CKV, TR_NITEMS = TR_NONEXPERT + 32 * (2 * TR_I_E + TR_I_D);
__device__ __forceinline__ TrDesc tr_mkdesc(const float* const* in, unsigned char* ws, int it) { TrDesc d; int r = it; d.gain = nullptr; d.kind = 0; d.base = 0;
    if (r < TR_I_IN) { d.W = in[3]; d.ldw = INW; d.K = D; d.nblk = 96; d.WT = (bf16*)(ws + WS_WIN); d.kind = 1; d.r = r; return d; } r -= TR_I_IN;
    if (r < TR_I_SQ) { d.W = in[14]; d.ldw = D; d.K = D; d.nblk = 32; d.WT = (bf16*)(ws + WS_WO); d.kind = 5; d.r = r; return d; } r -= TR_I_SQ;
    if (r < TR_I_SQ) { d.W = in[17]; d.ldw = D; d.K = D; d.nblk = 32; d.WT = (bf16*)(ws + WS_WCQ); d.gain = in[15]; d.kind = 3; d.r = r; return d; } r -= TR_I_SQ;
    if (r < TR_I_CKV) { d.W = in[18]; d.ldw = 2 * D; d.K = D; d.nblk = 64; d.WT = (bf16*)(ws + WS_WCKV); d.r = r; return d; } r -= TR_I_CKV;
    if (r < TR_I_SQ) { d.W = in[21]; d.ldw = D; d.K = D; d.nblk = 32; d.WT = (bf16*)(ws + WS_WCO); d.kind = 3; d.r = r; return d; } r -= TR_I_SQ;
    const int e = r / (2 * TR_I_E + TR_I_D); r -= e * (2 * TR_I_E + TR_I_D);
    if (r < TR_I_E) { d.W = in[27] + (size_t)e * D * 512; d.ldw = 512; d.K = D; d.nblk = 16; d.WT = (bf16*)(ws + WS_WGU); d.gain = in[22]; d.kind = 2; d.base = e * 1024; d.r = r; return d; } r -= TR_I_E;
    if (r < TR_I_E) { d.W = in[28] + (size_t)e * D * 512; d.ldw = 512; d.K = D; d.nblk = 16; d.WT = (bf16*)(ws + WS_WGU); d.gain = in[22]; d.kind = 2; d.base = e * 1024 + 128; d.r = r; return d; } r -= TR_I_E;
    d.W = in[29] + (size_t)e * 512 * D; d.ldw = D; d.K = 512; d.nblk = 32; d.WT = (bf16*)(ws + WS_WD); d.base = e * 1024; d.r = r; return d; }
__device__ __forceinline__ void tr_run(const float* const* in, unsigned char* ws, LAS float* scr, int lane, int first, int step, int last) {
    int it = first; TrDesc da_, db_; f32x4 wa[8], wb[8]; float ga[8], gb[8];
    if (it < last) { da_ = tr_mkdesc(in, ws, it); tr_load(da_, lane, wa, ga); }
    while (it < last) {
        const int i1 = it + step; if (i1 < last) { db_ = tr_mkdesc(in, ws, i1); tr_load(db_, lane, wb, gb); }
        tr_finish(da_, lane, wa, ga, scr);
        if (i1 >= last) break;
        const int i2 = i1 + step; if (i2 < last) { da_ = tr_mkdesc(in, ws, i2); tr_load(da_, lane, wa, ga); }
        tr_finish(db_, lane, wb, gb, scr);
        it = i2; }
}
__device__ __forceinline__ unsigned pack_i8x4(float a, float b, float c, float d) {
    unsigned r = __builtin_amdgcn_cvt_pk_u8_f32(a + 128.f, 0u, 0u); r = __builtin_amdgcn_cvt_pk_u8_f32(b + 128.f, 1u, r); r = __builtin_amdgcn_cvt_pk_u8_f32(c + 128.f, 2u, r); r = __builtin_amdgcn_cvt_pk_u8_f32(d + 128.f, 3u, r);
    return r ^ 0x80808080u;
}
__device__ __forceinline__ unsigned pack_fp8x4(float a, float b, float c, float d) {
    int r = __builtin_amdgcn_cvt_pk_fp8_f32(a, b, 0, false); r = __builtin_amdgcn_cvt_pk_fp8_f32(c, d, r, true); return (unsigned)r; }
__device__ __forceinline__ void win8_item(const float* __restrict__ W, unsigned char* W8, float* SB, int item, int lane) {
    const int n0 = 8 * item, c = lane & 3, r = lane >> 2;
    f32x2_t w[64];
#pragma unroll
    for (int i = 0; i < 64; ++i) w[i] = *(const GAS f32x2_t*)(W + (size_t)(64 * r + i) * INW + n0 + 2 * c);
    float m0 = 0.f, m1 = 0.f;
#pragma unroll
    for (int i = 0; i < 64; ++i) { m0 = fmaxf(m0, fabsf(w[i].x)); m1 = fmaxf(m1, fabsf(w[i].y)); }
#pragma unroll
    for (int o = 4; o < 64; o <<= 1) { m0 = fmaxf(m0, __shfl_xor(m0, o)); m1 = fmaxf(m1, __shfl_xor(m1, o)); }
    const float i0 = m0 > 0.f ? 127.f / m0 : 0.f, i1 = m1 > 0.f ? 127.f / m1 : 0.f;
    const RmIn rm;
    const int row0 = rm(n0 + 2 * c), row1 = rm(n0 + 2 * c + 1);
    GAS v4u* d0 = (GAS v4u*)(W8 + (size_t)row0 * D + 64 * r); GAS v4u* d1 = (GAS v4u*)(W8 + (size_t)row1 * D + 64 * r);
#pragma unroll
    for (int j = 0; j < 4; ++j) { v4u a, b;
#pragma unroll
        for (int q = 0; q < 4; ++q) { const int i = 16 * j + 4 * q;
            a[q] = pack_i8x4(w[i].x * i0, w[i + 1].x * i0, w[i + 2].x * i0, w[i + 3].x * i0);
            b[q] = pack_i8x4(w[i].y * i1, w[i + 1].y * i1, w[i + 2].y * i1, w[i + 3].y * i1); }
        d0[j] = a; d1[j] = b; }
    if (r == 0) { SB[row0] = m0 * (1.f / 127.f); SB[row1] = m1 * (1.f / 127.f); }
}
__device__ __forceinline__ void wo8_item(const float* __restrict__ W, const float* __restrict__ gda, const float* __restrict__ ggl, unsigned char* W8, float* SB, int item, int lane) {
    const int n0 = 8 * item, c = lane & 3, r = lane >> 2;
    const float* gp = (r < 8 ? gda : ggl) + ((64 * r) & 127); const float cf = r < 8 ? (1.f - LAM_INIT) * (MIX_RDA / 127.f) : (MIX_RGL / 127.f);
    f32x2_t w[64];
#pragma unroll
    for (int i = 0; i < 64; ++i) { const float f = gp[i] * cf; const f32x2_t t = *(const GAS f32x2_t*)(W + (size_t)(64 * r + i) * D + n0 + 2 * c); w[i].x = t.x * f; w[i].y = t.y * f; }
    float m0 = 0.f, m1 = 0.f;
#pragma unroll
    for (int i = 0; i < 64; ++i) { m0 = fmaxf(m0, fabsf(w[i].x)); m1 = fmaxf(m1, fabsf(w[i].y)); }
#pragma unroll
    for (int o = 4; o < 64; o <<= 1) { m0 = fmaxf(m0, __shfl_xor(m0, o)); m1 = fmaxf(m1, __shfl_xor(m1, o)); }
    const float i0 = m0 > 0.f ? 127.f / m0 : 0.f, i1 = m1 > 0.f ? 127.f / m1 : 0.f;
    const int row0 = n0 + 2 * c, row1 = row0 + 1;
    GAS v4u* d0 = (GAS v4u*)(W8 + (size_t)row0 * D + 64 * r); GAS v4u* d1 = (GAS v4u*)(W8 + (size_t)row1 * D + 64 * r);
#pragma unroll
    for (int j = 0; j < 4; ++j) { v4u a, b;
#pragma unroll
        for (int q = 0; q < 4; ++q) { const int i = 16 * j + 4 * q;
            a[q] = pack_i8x4(w[i].x * i0, w[i + 1].x * i0, w[i + 2].x * i0, w[i + 3].x * i0);
            b[q] = pack_i8x4(w[i].y * i1, w[i + 1].y * i1, w[i + 2].y * i1, w[i + 3].y * i1); }
        d0[j] = a; d1[j] = b; }
    if (r == 0) { SB[row0] = m0 * (1.f / 127.f); SB[row1] = m1 * (1.f / 127.f); }
}
struct CvSrc { const float* W; const float* gain; bf16* WT; int ldw, K, k0, n0, kind, ebase; };
__device__ __forceinline__ CvSrc cv_src(const float* const* in, unsigned char* ws, int tau) { CvSrc c;
    const int t32 = tau & 31; int e;
    if (tau < 2048) { const int mi = tau >> 5; e = mi >> 1; c.kind = mi & 1; } else { e = (tau - 2048) >> 5; c.kind = 2; }
    if (c.kind < 2) { c.W = (c.kind == 0 ? in[27] : in[28]) + (size_t)e * D * 512; c.ldw = 512; c.K = D; c.k0 = (t32 >> 2) * 128; c.n0 = (t32 & 3) * 128; c.WT = (bf16*)(ws + WS_WGU); c.ebase = e * 1024 + c.kind * 128; c.gain = in[22]; }
    else { c.W = in[29] + (size_t)e * 512 * D; c.ldw = D; c.K = 512; c.k0 = (t32 >> 3) * 128; c.n0 = (t32 & 7) * 128; c.WT = (bf16*)(ws + WS_WD); c.ebase = e * 1024; c.gain = nullptr; }
    return c; }
#define CV_BAR() asm volatile("s_waitcnt lgkmcnt(0)\n\ts_barrier" ::: "memory")
#define CV_LOAD(W_, G_, tau_) do { const CvSrc c_ = cv_src(in, ws, (tau_)); \
        _Pragma("unroll") for (int i_ = 0; i_ < 8; ++i_) { const int row_ = 16 * wv + 2 * i_ + (lane >> 5); W_[i_] = __builtin_nontemporal_load((const GAS f32x4*)(c_.W + (size_t)(c_.k0 + row_) * c_.ldw + c_.n0 + 4 * (lane & 31))); G_[i_] = c_.gain ? c_.gain[c_.k0 + row_] : 1.f; } } while (0)
#define CV_STEP(W_, G_, tau_, nxt_) do { \
        _Pragma("unroll") for (int i_ = 0; i_ < 8; ++i_) { const int row_ = 16 * wv + 2 * i_ + (lane >> 5); *(LAS f32x4*)(tile + row_ * 132 + ((4 * (lane & 31)) ^ (((row_ >> 4) & 7) << 2))) = W_[i_] * G_[i_]; }     \
        CV_BAR(); \
        if ((nxt_) < first + ntiles) CV_LOAD(W_, G_, (nxt_));                   \
        { const CvSrc c = cv_src(in, ws, (tau_)); \
          const int ch = tid & 15;                                             \
          _Pragma("unroll") for (int q = 0; q < 4; ++q) { const int n = (tid >> 4) + 32 * q; const LAS float* sp = tile + (8 * ch) * 132 + (n ^ (((ch >> 1) & 7) << 2)); \
              const int nn = c.n0 + n; const int row = (c.kind < 2) ? c.ebase + (nn >> 7) * 256 + (nn & 127) : c.ebase + nn; \
              if (c.kind == 2) { v2u o; o.x = pack_fp8x4(sp[0] * 16.f, sp[132] * 16.f, sp[264] * 16.f, sp[396] * 16.f); o.y = pack_fp8x4(sp[528] * 16.f, sp[660] * 16.f, sp[792] * 16.f, sp[924] * 16.f); \
                  *(GAS v2u*)((unsigned char*)c.WT + (size_t)row * c.K + c.k0 + 8 * ch) = o; } \
              else { v4u o; o.x = cvtpk_s(sp[0], sp[132]); o.y = cvtpk_s(sp[264], sp[396]); o.z = cvtpk_s(sp[528], sp[660]); o.w = cvtpk_s(sp[792], sp[924]); \
                  *(GAS v4u*)(c.WT + (size_t)row * c.K + c.k0 + 8 * ch) = o; } } } \
        CV_BAR(); } while (0)
__device__ __forceinline__ void conv_tiles(const float* const* in, unsigned char* ws, LAS float* tile, int tid, int first, int ntiles) {
    const int lane = tid & 63, wv = tid >> 6;
    f32x4 wA[8], wB[8]; float gA[8], gB[8];
    if (ntiles > 0) CV_LOAD(wA, gA, first);
    if (ntiles > 1) CV_LOAD(wB, gB, first + 1);
#pragma unroll 1
    for (int j = 0; j < ntiles; j += 2) {
        CV_STEP(wA, gA, first + j, first + j + 2);
        if (j + 1 < ntiles) CV_STEP(wB, gB, first + j + 1, first + j + 3);
    }
}
#undef CV_LOAD
#undef CV_STEP
#undef CV_BAR
#define C8_BAR() asm volatile("s_waitcnt lgkmcnt(0)\n\ts_barrier" ::: "memory")
#define C8_LOAD(beta_) do { const int mi_ = (beta_) >> 4; const float* W_ = ((mi_ & 1) ? in[28] : in[27]) + (size_t)(mi_ >> 1) * D * 512 + 32 * ((beta_) & 15) + 4 * (tid & 7); \
        _Pragma("unroll") for (int p_ = 0; p_ < 16; ++p_) { const int k_ = 64 * p_ + (tid >> 3); w[p_] = __builtin_nontemporal_load((const GAS f32x4*)(W_ + (size_t)k_ * 512)); g[p_] = in[22][k_]; } } while (0)
__device__ __forceinline__ void conv8_tiles(const float* const* in, unsigned char* ws, LAS float* tile, LAS float* smax, int tid, int first, int ntiles) {
    f32x4 w[16]; float g[16];
    if (ntiles > 0) C8_LOAD(first);
#pragma unroll 1
    for (int j = 0; j < ntiles; ++j) { const int beta = first + j;
#pragma unroll
        for (int p = 0; p < 16; ++p) *(LAS f32x4*)(tile + (64 * p + (tid >> 3)) * 32 + 4 * (tid & 7)) = w[p] * g[p];
        C8_BAR();
        if (j + 1 < ntiles) C8_LOAD(beta + 1);
        const int n = tid & 31, seg = tid >> 5;
        float col[64]; float m = 0.f;
#pragma unroll
        for (int i = 0; i < 64; ++i) { col[i] = tile[(64 * seg + i) * 32 + n]; m = fmaxf(m, fabsf(col[i])); }
        smax[seg * 32 + n] = m;
        C8_BAR();
        float cm = 0.f;
#pragma unroll
        for (int sg = 0; sg < 16; ++sg) cm = fmaxf(cm, smax[sg * 32 + n]);
        const float qi = cm > 0.f ? 256.f / cm : 0.f;
        const int mi = beta >> 4, nn = 32 * (beta & 15) + n, row = (mi >> 1) * 1024 + (nn >> 7) * 256 + (nn & 127) + (mi & 1) * 128;
        GAS v4u* dst = (GAS v4u*)(ws + WS_WGU + (size_t)row * D + 64 * seg);
#pragma unroll
        for (int jj = 0; jj < 4; ++jj) { v4u o;
#pragma unroll
            for (int q = 0; q < 4; ++q) { const int i = 16 * jj + 4 * q; o[q] = pk_fp8x4(col[i] * qi, col[i + 1] * qi, col[i + 2] * qi, col[i + 3] * qi); }
            dst[jj] = o; }
        if (seg == 0) ((float*)(ws + WS_SBGU))[row] = cm * (1.f / 256.f);
        C8_BAR();
    }
}
#undef C8_LOAD
#undef C8_BAR
__device__ __forceinline__ void quant_rows(const bf16* __restrict__ H, unsigned char* Q, const float* __restrict__ ssq, float* RS, int lane, int first, int count) {
    v4u a[4][2], b[4][2];
#pragma unroll
    for (int j = 0; j < 4; ++j) { const GAS v4u* p = (const GAS v4u*)(H + (size_t)(first + j) * D) + 2 * lane; a[j][0] = p[0]; a[j][1] = p[1]; }
#pragma unroll 1
    for (int r0 = first; r0 < first + count; r0 += 4) {
        if (r0 + 4 < first + count) {
#pragma unroll
            for (int j = 0; j < 4; ++j) { const GAS v4u* p = (const GAS v4u*)(H + (size_t)(r0 + 4 + j) * D) + 2 * lane; b[j][0] = p[0]; b[j][1] = p[1]; } }
#pragma unroll
        for (int j = 0; j < 4; ++j) {
            float v[16]; float am = 0.f;
#pragma unroll
            for (int h = 0; h < 2; ++h)
#pragma unroll
                for (int q = 0; q < 4; ++q) { const unsigned x = a[j][h][q]; v[8 * h + 2 * q] = __builtin_bit_cast(float, x << 16); v[8 * h + 2 * q + 1] = __builtin_bit_cast(float, x & 0xffff0000u); }
#pragma unroll
            for (int i = 0; i < 16; ++i) am = fmaxf(am, fabsf(v[i]));
            am = wave_max(am);
            const float qi = am > 0.f ? 127.f / am : 0.f;
            v4u o4;
#pragma unroll
            for (int q = 0; q < 4; ++q) o4[q] = pack_i8x4(v[4 * q] * qi, v[4 * q + 1] * qi, v[4 * q + 2] * qi, v[4 * q + 3] * qi);
            *((GAS v4u*)(Q + (size_t)(r0 + j) * D) + lane) = o4;
            if (lane == 0) { const f32x4 q4 = *(const f32x4*)(ssq + (size_t)(r0 + j) * 4); RS[r0 + j] = rsqrtf(((q4[0] + q4[1]) + (q4[2] + q4[3])) * (1.f / D) + EPS) * am * (1.f / 127.f); }
        }
#pragma unroll
        for (int j = 0; j < 4; ++j) { a[j][0] = b[j][0]; a[j][1] = b[j][1]; }
    }
}
__device__ __forceinline__ void refresh(Frame& F) { int t = my_tid(); asm volatile("" : "+v"(t)); F.tid = t; F.lane = t & 63; F.wave = __builtin_amdgcn_readfirstlane(t >> 6); }
__device__ __forceinline__ void p0_prologue(Frame& F0, const float* const* in, unsigned char* ws) {
    Frame F = F0; refresh(F);
    LAS float* scr = (LAS float*)(F.lds + RING_OFF + F.wave * 16384);
    const int gw = F.vcu * NWAVES + F.wave, NGW = F.G * NWAVES;
    if (F.vcu < 96 && F.wave < 4) win8_item(in[3], ws + WS_WIN, (float*)(ws + WS_SB), F.vcu * 4 + F.wave, F.lane);
    if (F.vcu >= 96 && F.vcu < 128 && F.wave < 4) wo8_item(in[14], in[10], in[13], ws + WS_WO, (float*)(ws + WS_SBO), (F.vcu - 96) * 4 + F.wave, F.lane);
    tr_run(in, ws, scr, F.lane, TR_I_IN + gw, NGW, TR_NONEXPERT);
    __syncthreads();
    LAS float* wgr = (LAS float*)(F.lds + RING_OFF);
    for (int i = F.tid; i < 16384; i += NWAVES * 64) { const int k = i >> 4, r = i & 15; wgr[r * 1024 + k] = in[3][(size_t)k * INW + 3072 + r]; }
    __syncthreads();
    const float* x = in[0]; const float* g = in[2]; unsigned char* U8 = ws + WS_RA; float* SA = (float*)(ws + WS_SA); float* GR = (float*)(ws + WS_GR);
    f32x4 vnx[4];
    if (gw < T) {
#pragma unroll
        for (int j = 0; j < 4; ++j) vnx[j] = ((const GAS f32x4*)(x + (size_t)gw * D) + F.lane)[64 * j]; }
    for (int m = gw; m < T; m += NGW) {
        f32x4 v[4]; float s = 0.f;
#pragma unroll
        for (int j = 0; j < 4; ++j) v[j] = vnx[j];
        if (m + NGW < T) {
#pragma unroll
            for (int j = 0; j < 4; ++j) vnx[j] = ((const GAS f32x4*)(x + (size_t)(m + NGW) * D) + F.lane)[64 * j]; }
#pragma unroll
        for (int j = 0; j < 4; ++j) s += (v[j].x * v[j].x + v[j].y * v[j].y) + (v[j].z * v[j].z + v[j].w * v[j].w);
        const float rstd = rsqrtf(wave_sum(s) * (1.f / D) + EPS);
        GAS unsigned* o4 = (GAS unsigned*)(U8 + (size_t)m * D) + F.lane;
        float p[16];
#pragma unroll
        for (int r = 0; r < 16; ++r) p[r] = 0.f;
        float am = 0.f;
#pragma unroll
        for (int j = 0; j < 4; ++j) { const f32x4 gg = ((const GAS f32x4*)g)[F.lane + 64 * j]; v[j] = v[j] * rstd * gg;
            am = fmaxf(fmaxf(am, fmaxf(fabsf(v[j].x), fabsf(v[j].y))), fmaxf(fabsf(v[j].z), fabsf(v[j].w))); }
        am = wave_max(am);
        const float qi = am > 0.f ? 127.f / am : 0.f;
        if (F.lane == 0) SA[m] = am * (1.f / 127.f);
#pragma unroll
        for (int j = 0; j < 4; ++j) o4[64 * j] = pack_i8x4(v[j].x * qi, v[j].y * qi, v[j].z * qi, v[j].w * qi);
        { f32x4 wc[4], wn[4];
#pragma unroll
          for (int q = 0; q < 4; ++q) wc[q] = *(const LAS f32x4*)(wgr + q * 1024 + 4 * F.lane);
#pragma unroll
          for (int gI = 0; gI < 16; ++gI) { const int j = gI >> 2, rg = gI & 3;
              if (gI + 1 < 16) { const int jn = (gI + 1) >> 2, rn = (gI + 1) & 3;
#pragma unroll
                  for (int q = 0; q < 4; ++q) wn[q] = *(const LAS f32x4*)(wgr + (4 * rn + q) * 1024 + 4 * (F.lane + 64 * jn)); }
              __builtin_amdgcn_sched_barrier(0);
#pragma unroll
              for (int q = 0; q < 4; ++q) { const f32x4 w = wc[q]; p[4 * rg + q] += (v[j].x * w.x + v[j].y * w.y) + (v[j].z * w.z + v[j].w * w.w); }
              __builtin_amdgcn_sched_barrier(0);
#pragma unroll
              for (int q = 0; q < 4; ++q) wc[q] = wn[q]; } }
        { const bool b5 = (F.lane & 32) != 0, b4 = (F.lane & 16) != 0, b3 = (F.lane & 8) != 0, b2 = (F.lane & 4) != 0;
#pragma unroll
          for (int i = 0; i < 8; ++i) { const float send = b5 ? p[i] : p[i + 8], keep = b5 ? p[i + 8] : p[i]; p[i] = keep + __shfl_xor(send, 32); }
#pragma unroll
          for (int i = 0; i < 4; ++i) { const float send = b4 ? p[i] : p[i + 4], keep = b4 ? p[i + 4] : p[i]; p[i] = keep + __shfl_xor(send, 16); }
#pragma unroll
          for (int i = 0; i < 2; ++i) { const float send = b3 ? p[i] : p[i + 2], keep = b3 ? p[i + 2] : p[i]; p[i] = keep + __shfl_xor(send, 8); }
          { const float send = b2 ? p[0] : p[1], keep = b2 ? p[1] : p[0]; p[0] = keep + __shfl_xor(send, 4); }
          p[0] += __shfl_xor(p[0], 2); p[0] += __shfl_xor(p[0], 1);
          if ((F.lane & 3) == 0) GR[(size_t)m * 16 + ((F.lane >> 2) & 15)] = p[0]; }
    }
    { bf16* WR = (bf16*)(ws + WS_WR); const float* gf = in[22]; const float* wgp = in[23]; const float* wep = in[25];
      for (int i = gw * 64 + F.lane; i < 256 * 1024; i += NGW * 64) { const int r = i >> 10, k = i & 1023, c = r & 127; unsigned short o = 0;
          if (c < 36) { const float w = gf[k] * (c < 32 ? wep[k * 32 + c] : wgp[k * 4 + (c - 32)]); const unsigned hi_ = f2bf(w); o = (unsigned short)((r < 128) ? hi_ : f2bf(w - bf2f((unsigned short)hi_))); }
          WR[i] = o; } }
    { GAS v4u* L4 = (GAS v4u*)(ws + WS_LIST); for (int i = gw * 64 + F.lane; i < 64 * CAP / 4; i += NGW * 64) L4[i] = (v4u){0u, 0u, 0u, 0u}; }
    const float* mem = in[1]; const float* gm = in[16]; bf16* MN = (bf16*)(ws + WS_MN);
    for (int m = gw; m < TM; m += NGW) {
        const GAS f32x4* xr = (const GAS f32x4*)(mem + (size_t)m * D) + F.lane;
        f32x4 v[4]; float s = 0.f;
#pragma unroll
        for (int j = 0; j < 4; ++j) { v[j] = xr[64 * j]; s += (v[j].x * v[j].x + v[j].y * v[j].y) + (v[j].z * v[j].z + v[j].w * v[j].w); }
        const float rstd = rsqrtf(wave_sum(s) * (1.f / D) + EPS);
        GAS unsigned long long* o8 = (GAS unsigned long long*)(MN + (size_t)m * D) + F.lane;
#pragma unroll
        for (int j = 0; j < 4; ++j) { const f32x4 gg = ((const GAS f32x4*)gm)[F.lane + 64 * j]; v[j] = v[j] * rstd * gg;
            o8[64 * j] = (unsigned long long)pk2(v[j].x, v[j].y) | ((unsigned long long)pk2(v[j].z, v[j].w) << 32); }
    }
}

struct OrderMN {
    struct Unit { int pm, pn; };
    const char* A; const char* B; int lda, ldb; int nM, nN, nwg, G, c; int i0 = 0, i1 = 1 << 30;
    __device__ __forceinline__ void init(const void* A_, int lda_, const void* B_, int ldb_, int M, int N, int G_, int c_) { A = (const char*)A_; B = (const char*)B_; lda = lda_; ldb = ldb_; nM = M / 256; nN = N / 256; nwg = nM * nN; G = G_; c = c_; }
    __device__ __forceinline__ bool next(int i, Unit& u) const {
        const int ii = i + i0; if (ii >= i1) return false;
        const long L = (long)ii * G + c; if (L >= nwg || c < 0) return false;
        int wgid = (int)L; { const int q = nwg / 8, r = nwg % 8, xcd = wgid % 8, off = wgid / 8; wgid = (xcd < r ? xcd * (q + 1) : r * (q + 1) + (xcd - r) * q) + off; }
        const int nig = 8 * nN, gid = wgid / nig, fm = gid * 8, gsz = (nM - fm) < 8 ? (nM - fm) : 8;
        u.pm = fm + ((wgid % nig) % gsz); u.pn = (wgid % nig) / gsz; return true;
    }
    __device__ __forceinline__ const char* pa(const Unit& u) const { return A + (size_t)u.pm * 256 * lda; }
    __device__ __forceinline__ const char* pb(const Unit& u) const { return B + (size_t)u.pn * 256 * ldb; }
};
__device__ __forceinline__ void st8(bf16* p, const f32x4& a, const f32x4& b) { v4u w; w.x = cvtpk_s(a[0], a[1]); w.y = cvtpk_s(a[2], a[3]); w.z = cvtpk_s(b[0], b[1]); w.w = cvtpk_s(b[2], b[3]); *(v4u*)p = w; }
__device__ __forceinline__ void st8x(bf16* p_new, const f32x4& a, const f32x4& b, int pull4) {
    v4u w; w.x = cvtpk_s(a[0], a[1]); w.y = cvtpk_s(a[2], a[3]); w.z = cvtpk_s(b[0], b[1]); w.w = cvtpk_s(b[2], b[3]);
    v4u o; o.x = (unsigned)__builtin_amdgcn_ds_bpermute(pull4, (int)w.x); o.y = (unsigned)__builtin_amdgcn_ds_bpermute(pull4, (int)w.y); o.z = (unsigned)__builtin_amdgcn_ds_bpermute(pull4, (int)w.z); o.w = (unsigned)__builtin_amdgcn_ds_bpermute(pull4, (int)w.w);
    *(v4u*)p_new = o; }
#define ST8X_ROLE() const int ln_ = fr + 16 * fq, fr2 = ln_ >> 2, fq2 = ln_ & 3, pull4 = 4 * (fr2 + 16 * fq2)
__device__ __forceinline__ float silu_f(float v) { return v * __builtin_amdgcn_rcpf(1.f + __builtin_amdgcn_exp2f(-LOG2E * v)); }

struct EpiIn {
    static constexpr bool PERM = true;
    bf16 *DQ, *DK, *DV, *GQ, *GK, *GV, *GG; const float *qn, *kn; const float *SA, *SB; LAS float* xl;
    using Pre = int;
    __device__ __forceinline__ void prefetch(const OrderMN::Unit& u, int wr, int wid, int lane, const LAS int*) const {
#pragma unroll
        for (int ai = 0; ai < 2; ++ai) __builtin_amdgcn_global_load_lds((const unsigned*)(SA + (size_t)u.pm * 256 + ai * 128 + wr * 64 + lane), (LAS unsigned*)(xl + wid * 128 + ai * 64), 4, 0, 0);
    }
#define EI_X(ai, bj, m, n) (__builtin_convertvector(__builtin_bit_cast(i32x4, acc[ai][bj][m][n]), f32x4) * (sbv[bj][n] * sar))
    __device__ __forceinline__ void operator()(const f32x4 (&acc)[2][2][4][2], const OrderMN::Unit& u, int wr, int wc, int fr, int fq) const {
        const int tile = u.pn; const size_t row0 = (size_t)u.pm * 256 + wr * 64 + fr;
        ST8X_ROLE(); const size_t row0b = (size_t)u.pm * 256 + wr * 64 + fr2;
        f32x4 sbv[2][2];
#pragma unroll
        for (int bj = 0; bj < 2; ++bj)
#pragma unroll
            for (int n = 0; n < 2; ++n) sbv[bj][n] = *(const f32x4*)(SB + tile * 256 + 128 * bj + 32 * wc + 8 * fq + 4 * n);
        float sa8[8];
#pragma unroll
        for (int it = 0; it < 8; ++it) sa8[it] = xl[(wr * 4 + wc) * 128 + (it >> 2) * 64 + (it & 3) * 16 + fr];
        if (tile < 4) {
            const float* g = tile < 2 ? qn : kn; const float sc = tile < 2 ? QSCALE : 1.f;
            const bool img = tile >= 2;
            bf16* dst = (tile < 2 ? DQ : DK) + (tile & 1) * 256 + 64 * wc + 8 * fq;
            f32x4 gv[2][2];
#pragma unroll
            for (int bj = 0; bj < 2; ++bj)
#pragma unroll
                for (int n = 0; n < 2; ++n) gv[bj][n] = *(const f32x4*)(g + 32 * bj + 8 * fq + 4 * n) * sc;
#pragma unroll
            for (int ai = 0; ai < 2; ++ai)
#pragma unroll
                for (int m = 0; m < 4; ++m) {
                    const size_t tk = row0 + ai * 128 + m * 16;
                    const float sar = sa8[ai * 4 + m];
                    f32x4 xv[2][2];
                    float ss = 0.f;
#pragma unroll
                    for (int bj = 0; bj < 2; ++bj)
#pragma unroll
                        for (int n = 0; n < 2; ++n) { const f32x4 x = EI_X(ai, bj, m, n); xv[bj][n] = x; ss += (x[0] * x[0] + x[1] * x[1]) + (x[2] * x[2] + x[3] * x[3]); }
                    ss += __shfl_xor(ss, 16); ss += __shfl_xor(ss, 32);
                    const float r = rsqrtf(ss * (1.f / 64.f) + EPS);
                    bf16* rowp = dst + tk * 512; int cst = 32;
                    if (img) { const int hh = (tile & 1) * 2 + (wc >> 1), bb = (int)(tk >> 12), ss = (int)(tk & 4095);
                        rowp = DK + ((size_t)((bb * 4 + hh) * 64 + (ss >> 6))) * 8192 + (wc & 1) * 4096 + fq * 512 + (ss & 63) * 8; cst = 2048; }
                    if (img) {
#pragma unroll
                        for (int bj = 0; bj < 2; ++bj) st8(rowp + cst * bj, xv[bj][0] * r * gv[bj][0], xv[bj][1] * r * gv[bj][1]);
                    } else { bf16* rowq = DQ + (tile & 1) * 256 + 64 * wc + 8 * fq2 + (row0b + ai * 128 + m * 16) * 512;
#pragma unroll
                        for (int bj = 0; bj < 2; ++bj) st8x(rowq + 32 * bj, xv[bj][0] * r * gv[bj][0], xv[bj][1] * r * gv[bj][1], pull4); }
                }
        } else {
            bf16* dst; int ld; float sc = 1.f; bool act = false;
            if (tile < 6) { dst = DV + (tile - 4) * 256; ld = 512; }
            else if (tile == 6) { dst = GQ; ld = 256; sc = 0.125f; }
            else if (tile == 7) { dst = GK; ld = 256; }
            else if (tile < 10) { dst = GV + (tile - 8) * 256; ld = 512; }
            else { dst = GG + (tile - 10) * 256; ld = 512; act = true; }
            dst += wc * 32 + 8 * fq2;
            const bool vimg = tile < 6;
#pragma unroll
            for (int ai = 0; ai < 2; ++ai)
#pragma unroll
                for (int m = 0; m < 4; ++m) { const size_t tk = row0 + ai * 128 + m * 16, tk2 = row0b + ai * 128 + m * 16; bf16* rowp = dst + tk2 * ld; int cst = 128; const float sar = sa8[ai * 4 + m] * sc;
                    if (vimg) { const int bb = (int)(tk2 >> 12), ss = (int)(tk2 & 4095), rr = ss & 63;
                        rowp = DV + ((size_t)((bb * 4 + (tile - 4) * 2) * 64 + (ss >> 6))) * 8192 + (wc * 4 + (rr >> 4)) * 512 + (rr & 15) * 32 + 8 * fq2; cst = 64 * 8192; }
#pragma unroll
                    for (int bj = 0; bj < 2; ++bj) { f32x4 v0 = EI_X(ai, bj, m, 0), v1 = EI_X(ai, bj, m, 1);
                        if (act) {
#pragma unroll
                            for (int i = 0; i < 4; ++i) { v0[i] = silu_f(v0[i]); v1[i] = silu_f(v1[i]); } }
                        st8x(rowp + (size_t)cst * bj, v0, v1, pull4); } }
        }
    }
};
#undef EI_X
struct EpiNorm256 {
    static constexpr bool PERM = true;
    bf16* O; int ldo; const float* gain; const float* ssq; float post; LAS float* xch;
    template <class UnitT> __device__ __forceinline__ void operator()(const f32x4 (&acc)[2][2][4][2], const UnitT& u, int wr, int wc, int fr, int fq) const {
        const size_t row0 = (size_t)u.pm * 256 + wr * 64 + fr;
        float rs[2][4];
#pragma unroll
        for (int ai = 0; ai < 2; ++ai)
#pragma unroll
            for (int m = 0; m < 4; ++m) {
                float r = 1.f;
                if (ssq) { const f32x4 q = *(const f32x4*)(ssq + (row0 + ai * 128 + m * 16) * 4); r = rsqrtf(((q[0] + q[1]) + (q[2] + q[3])) * (1.f / D) + EPS); }
                rs[ai][m] = r;
                float ss = 0.f;
#pragma unroll
                for (int bj = 0; bj < 2; ++bj)
#pragma unroll
                    for (int n = 0; n < 2; ++n) { const f32x4 x = acc[ai][bj][m][n] * r; ss += (x[0] * x[0] + x[1] * x[1]) + (x[2] * x[2] + x[3] * x[3]); }
                ss += __shfl_xor(ss, 16); ss += __shfl_xor(ss, 32);
                if (fq == 0) xch[(ai * 128 + wr * 64 + m * 16 + fr) * 4 + wc] = ss;
            }
        asm volatile("s_waitcnt lgkmcnt(0)" ::: "memory"); __builtin_amdgcn_s_barrier(); asm volatile("" ::: "memory");
        f32x4 gv[2][2];
#pragma unroll
        for (int bj = 0; bj < 2; ++bj)
#pragma unroll
            for (int n = 0; n < 2; ++n) gv[bj][n] = *(const f32x4*)(gain + 128 * bj + 32 * wc + 8 * fq + 4 * n) * post;
        ST8X_ROLE();
        unsigned char* dst = (unsigned char*)O + (size_t)u.pn * 256 + wc * 32 + 8 * fq2;
#pragma unroll
        for (int ai = 0; ai < 2; ++ai)
#pragma unroll
            for (int m = 0; m < 4; ++m) {
                const f32x4 q = *(const LAS f32x4*)(xch + (ai * 128 + wr * 64 + m * 16 + fr) * 4);
                const float r = rs[ai][m] * rsqrtf(((q[0] + q[1]) + (q[2] + q[3])) * (1.f / 256.f) + EPS);
                unsigned char* rowp = dst + ((size_t)u.pm * 256 + wr * 64 + fr2 + ai * 128 + m * 16) * ldo;
#pragma unroll
                for (int bj = 0; bj < 2; ++bj) { const f32x4 a_ = acc[ai][bj][m][0] * r * gv[bj][0], b_ = acc[ai][bj][m][1] * r * gv[bj][1];
                    v2u w_; w_.x = pk_fp8x4(a_[0], a_[1], a_[2], a_[3]); w_.y = pk_fp8x4(b_[0], b_[1], b_[2], b_[3]);
                    v2u o_; o_.x = (unsigned)__builtin_amdgcn_ds_bpermute(pull4, (int)w_.x); o_.y = (unsigned)__builtin_amdgcn_ds_bpermute(pull4, (int)w_.y);
                    *(v2u*)(rowp + 128 * bj) = o_; }
            }
    }
};
struct EpiPlain {
    static constexpr bool PERM = true;
    bf16* O; int ldo;
    __device__ __forceinline__ void operator()(const f32x4 (&acc)[2][2][4][2], const OrderMN::Unit& u, int wr, int wc, int fr, int fq) const {
        ST8X_ROLE();
        unsigned char* dst8 = (unsigned char*)O + ((size_t)u.pm * 256 + wr * 64 + fr2) * ldo + (size_t)u.pn * 256 + wc * 32 + 8 * fq2;
#pragma unroll
        for (int ai = 0; ai < 2; ++ai)
#pragma unroll
            for (int m = 0; m < 4; ++m)
#pragma unroll
                for (int bj = 0; bj < 2; ++bj) { const f32x4 a_ = acc[ai][bj][m][0], b_ = acc[ai][bj][m][1];
                    v2u w_; w_.x = pk_fp8x4(a_[0], a_[1], a_[2], a_[3]); w_.y = pk_fp8x4(b_[0], b_[1], b_[2], b_[3]);
                    v2u o_; o_.x = (unsigned)__builtin_amdgcn_ds_bpermute(pull4, (int)w_.x); o_.y = (unsigned)__builtin_amdgcn_ds_bpermute(pull4, (int)w_.y);
                    *(v2u*)(dst8 + (size_t)(ai * 128 + m * 16) * ldo + 128 * bj) = o_; }
    }
};

template <bool BASE_BF16, bool SSQ, bool I8E = false>
struct EpiRes {
    static constexpr bool PERM = true;
    const void* base; bf16* OB; float* ssq; LAS float* xch; float asc; unsigned char* O8; const float* SBC = nullptr;
    struct BaseRegs { f32x4 f[2][2]; v4u h[2]; };
    __device__ __forceinline__ void ld(BaseRegs& r, size_t off) const {
        if constexpr (BASE_BF16) { r.h[0] = *(const v4u*)((const bf16*)base + off); r.h[1] = *(const v4u*)((const bf16*)base + off + 128); }
        else { r.f[0][0] = *(const f32x4*)((const float*)base + off); r.f[0][1] = *(const f32x4*)((const float*)base + off + 4); r.f[1][0] = *(const f32x4*)((const float*)base + off + 128); r.f[1][1] = *(const f32x4*)((const float*)base + off + 132); } }
    __device__ __forceinline__ void get(const BaseRegs& r, int bj, f32x4& b0, f32x4& b1) const {
        if constexpr (BASE_BF16) { const v4u w = r.h[bj];
            b0 = (f32x4){__builtin_bit_cast(float, w.x << 16), __builtin_bit_cast(float, w.x & 0xffff0000u), __builtin_bit_cast(float, w.y << 16), __builtin_bit_cast(float, w.y & 0xffff0000u)};
            b1 = (f32x4){__builtin_bit_cast(float, w.z << 16), __builtin_bit_cast(float, w.z & 0xffff0000u), __builtin_bit_cast(float, w.w << 16), __builtin_bit_cast(float, w.w & 0xffff0000u)}; }
        else { b0 = r.f[bj][0]; b1 = r.f[bj][1]; } }
    __device__ __forceinline__ void operator()(const f32x4 (&acc)[2][2][4][2], const OrderMN::Unit& u, int wr, int wc, int fr, int fq) const {
        ST8X_ROLE(); const size_t offb = ((size_t)u.pm * 256 + wr * 64 + fr2) * 1024 + u.pn * 256 + wc * 32 + 8 * fq2;
        f32x4 cs[2][2];
        if constexpr (I8E) {
#pragma unroll
            for (int bj = 0; bj < 2; ++bj)
#pragma unroll
                for (int n = 0; n < 2; ++n) cs[bj][n] = *(const f32x4*)(SBC + u.pn * 256 + 128 * bj + 32 * wc + 8 * fq + 4 * n); }
        BaseRegs br[4];
        ld(br[0], offb); ld(br[1], offb + (size_t)16 * 1024); ld(br[2], offb + (size_t)32 * 1024); ld(br[3], offb + (size_t)48 * 1024);
#pragma unroll
        for (int it = 0; it < 8; ++it) { const int ai = it >> 2, m = it & 3; const size_t off = offb + (size_t)(ai * 128 + m * 16) * 1024; float ss = 0.f;
            v4u wa[2];
#pragma unroll
            for (int bj = 0; bj < 2; ++bj) { f32x4 a0, a1;
                if constexpr (I8E) { a0 = __builtin_convertvector(__builtin_bit_cast(i32x4, acc[ai][bj][m][0]), f32x4) * cs[bj][0]; a1 = __builtin_convertvector(__builtin_bit_cast(i32x4, acc[ai][bj][m][1]), f32x4) * cs[bj][1]; }
                else { a0 = acc[ai][bj][m][0] * asc; a1 = acc[ai][bj][m][1] * asc; }
                wa[bj].x = (unsigned)__builtin_amdgcn_ds_bpermute(pull4, (int)cvtpk_s(a0[0], a0[1])); wa[bj].y = (unsigned)__builtin_amdgcn_ds_bpermute(pull4, (int)cvtpk_s(a0[2], a0[3]));
                wa[bj].z = (unsigned)__builtin_amdgcn_ds_bpermute(pull4, (int)cvtpk_s(a1[0], a1[1])); wa[bj].w = (unsigned)__builtin_amdgcn_ds_bpermute(pull4, (int)cvtpk_s(a1[2], a1[3])); }
            f32x4 b00, b01, b10, b11; get(br[it & 3], 0, b00, b01); get(br[it & 3], 1, b10, b11);
            if (it + 4 < 8) ld(br[it & 3], offb + (size_t)(128 + (it & 3) * 16) * 1024);
#pragma unroll
            for (int bj = 0; bj < 2; ++bj) { const v4u w = wa[bj];
                const f32x4 c0 = (f32x4){__builtin_bit_cast(float, w.x << 16), __builtin_bit_cast(float, w.x & 0xffff0000u), __builtin_bit_cast(float, w.y << 16), __builtin_bit_cast(float, w.y & 0xffff0000u)};
                const f32x4 c1 = (f32x4){__builtin_bit_cast(float, w.z << 16), __builtin_bit_cast(float, w.z & 0xffff0000u), __builtin_bit_cast(float, w.w << 16), __builtin_bit_cast(float, w.w & 0xffff0000u)};
                const f32x4 h0 = (bj ? b10 : b00) + c0, h1 = (bj ? b11 : b01) + c1;
                st8(OB + off + 128 * bj, h0, h1);
                { v2u w8_; w8_.x = pk_fp8x4(h0[0], h0[1], h0[2], h0[3]); w8_.y = pk_fp8x4(h1[0], h1[1], h1[2], h1[3]); *(v2u*)(O8 + off + 128 * bj) = w8_; }
                if constexpr (SSQ) ss += ((h0[0] * h0[0] + h0[1] * h0[1]) + (h0[2] * h0[2] + h0[3] * h0[3])) + ((h1[0] * h1[0] + h1[1] * h1[1]) + (h1[2] * h1[2] + h1[3] * h1[3])); }
            if constexpr (SSQ) { ss += __shfl_xor(ss, 1); ss += __shfl_xor(ss, 2);
                if (fq2 == 0) xch[(ai * 128 + wr * 64 + m * 16 + fr2) * 4 + wc] = ss; } }
        if constexpr (SSQ) {
        asm volatile("s_waitcnt lgkmcnt(0)" ::: "memory"); __builtin_amdgcn_s_barrier(); asm volatile("" ::: "memory");
        const size_t row0 = (size_t)u.pm * 256 + wr * 64 + fr;
        if (wc == 0 && fq == 0) {
#pragma unroll
            for (int ai = 0; ai < 2; ++ai)
#pragma unroll
                for (int m = 0; m < 4; ++m) { const f32x4 q = *(const LAS f32x4*)(xch + (ai * 128 + wr * 64 + m * 16 + fr) * 4); ssq[(row0 + ai * 128 + m * 16) * 4 + u.pn] = (q[0] + q[1]) + (q[2] + q[3]); } } }
    }
};
struct OrderPanel {
    struct Unit { int pm, pn; };
    const char* A; const char* B; int G, c;
    __device__ __forceinline__ bool next(int i, Unit& u) const { const int L = i * G + c; if (L >= 512) return false; u.pm = L >> 2; u.pn = L & 3; return true; }
    __device__ __forceinline__ const char* pa(const Unit& u) const { return A + (size_t)u.pm * 256 * 1024; }
    __device__ __forceinline__ const char* pb(const Unit& u) const { return B + (size_t)u.pn * 256 * 1024; }
};
struct OrderCross {
    struct Unit { int pm, pn; };
    const char* A; const char* B; int ldb, bstride, hstrideB; int G, c; int pitchA = 2048, headA = 512;
    __device__ __forceinline__ bool next(int i, Unit& u) const { const int L = i * G + c; if (L >= 512) return false; u.pm = L >> 2; u.pn = L & 3; return true; }
    __device__ __forceinline__ const char* pa(const Unit& u) const { return A + (size_t)u.pm * 256 * pitchA + u.pn * headA; }
    __device__ __forceinline__ const char* pb(const Unit& u) const { return B + (size_t)(u.pm >> 4) * bstride + (size_t)u.pn * hstrideB; }
};
struct EpiSoftmax {
    static constexpr bool PERM = true;
    bf16* P; float* rsum; LAS float* xch;
    __device__ __forceinline__ void operator()(const f32x4 (&acc)[2][2][4][2], const OrderCross::Unit& u, int wr, int wc, int fr, int fq) const {
        const size_t row0 = (size_t)u.pm * 256 + wr * 64 + fr;
#pragma unroll
        for (int ai = 0; ai < 2; ++ai)
#pragma unroll
            for (int m = 0; m < 4; ++m) { float mx = -1e30f;
#pragma unroll
                for (int bj = 0; bj < 2; ++bj)
#pragma unroll
                    for (int n = 0; n < 2; ++n) { const f32x4 x = acc[ai][bj][m][n]; mx = fmaxf(mx, fmaxf(fmaxf(x[0], x[1]), fmaxf(x[2], x[3]))); }
                mx = fmaxf(mx, __shfl_xor(mx, 16)); mx = fmaxf(mx, __shfl_xor(mx, 32));
                if (fq == 0) xch[(ai * 128 + wr * 64 + m * 16 + fr) * 4 + wc] = mx; }
        asm volatile("s_waitcnt lgkmcnt(0)" ::: "memory"); __builtin_amdgcn_s_barrier(); asm volatile("" ::: "memory");
        ST8X_ROLE();
        unsigned char* dst8 = (unsigned char*)P + ((size_t)u.pm * 256 + wr * 64 + fr2) * 1024 + (size_t)u.pn * 256 + wc * 32 + 8 * fq2;
#pragma unroll
        for (int ai = 0; ai < 2; ++ai)
#pragma unroll
            for (int m = 0; m < 4; ++m) { const f32x4 q = *(const LAS f32x4*)(xch + (ai * 128 + wr * 64 + m * 16 + fr) * 4); const float mx = fmaxf(fmaxf(q[0], q[1]), fmaxf(q[2], q[3]));
                const size_t row = row0 + ai * 128 + m * 16; float ss = 0.f;
#pragma unroll
                for (int bj = 0; bj < 2; ++bj) { f32x4 e0, e1;
#pragma unroll
                    for (int i = 0; i < 4; ++i) { e0[i] = __builtin_amdgcn_exp2f((acc[ai][bj][m][0][i] - mx) * 0.0625f + 8.f); e1[i] = __builtin_amdgcn_exp2f((acc[ai][bj][m][1][i] - mx) * 0.0625f + 8.f); }
                    v2u w; w.x = pk_fp8x4(e0[0], e0[1], e0[2], e0[3]); w.y = pk_fp8x4(e1[0], e1[1], e1[2], e1[3]);
                    { v2u o_; o_.x = (unsigned)__builtin_amdgcn_ds_bpermute(pull4, (int)w.x); o_.y = (unsigned)__builtin_amdgcn_ds_bpermute(pull4, (int)w.y);
                      *(v2u*)(dst8 + (size_t)(ai * 128 + m * 16) * 1024 + 128 * bj) = o_; }
                    { const f32x2_t r0_ = __builtin_amdgcn_cvt_pk_f32_fp8((int)w.x, false), r1_ = __builtin_amdgcn_cvt_pk_f32_fp8((int)w.x, true), r2_ = __builtin_amdgcn_cvt_pk_f32_fp8((int)w.y, false), r3_ = __builtin_amdgcn_cvt_pk_f32_fp8((int)w.y, true);
                      ss += ((r0_.x + r0_.y) + (r1_.x + r1_.y)) + ((r2_.x + r2_.y) + (r3_.x + r3_.y)); } }
                ss += __shfl_xor(ss, 16); ss += __shfl_xor(ss, 32);
                if (fq == 0) rsum[(row * 4 + u.pn) * 4 + wc] = ss;
                asm volatile("" ::: "memory"); }
    }
};
struct EpiPV {
    static constexpr bool PERM = true;
    bf16* O; const float* rsum;
    __device__ __forceinline__ void operator()(const f32x4 (&acc)[2][2][4][2], const OrderCross::Unit& u, int wr, int wc, int fr, int fq) const {
        ST8X_ROLE();
        const size_t row0 = (size_t)u.pm * 256 + wr * 64 + fr; unsigned char* dst = (unsigned char*)O + ((size_t)u.pm * 256 + wr * 64 + fr2) * 1024 + (size_t)u.pn * 256 + wc * 32 + 8 * fq2;
#pragma unroll
        for (int ai = 0; ai < 2; ++ai) {
            float inv4[4];
#pragma unroll
            for (int it = 0; it < 4; ++it) { const size_t row = row0 + ai * 128 + it * 16; const f32x4 q = *(const f32x4*)(rsum + (row * 4 + u.pn) * 4); inv4[it] = 1.f / ((q[0] + q[1]) + (q[2] + q[3])); }
#pragma unroll
            for (int m = 0; m < 4; ++m) { const size_t row = row0 + ai * 128 + m * 16; const float inv = inv4[m];
#pragma unroll
                for (int bj = 0; bj < 2; ++bj) { const f32x4 a_ = acc[ai][bj][m][0] * inv, b_ = acc[ai][bj][m][1] * inv;
                    v2u w_; w_.x = pk_fp8x4(a_[0], a_[1], a_[2], a_[3]); w_.y = pk_fp8x4(b_[0], b_[1], b_[2], b_[3]);
                    v2u o_; o_.x = (unsigned)__builtin_amdgcn_ds_bpermute(pull4, (int)w_.x); o_.y = (unsigned)__builtin_amdgcn_ds_bpermute(pull4, (int)w_.y);
                    *(v2u*)(dst + (size_t)(ai * 128 + m * 16) * 1024 + 128 * bj) = o_; } }
            asm volatile("" ::: "memory"); }
    }
};

__device__ __forceinline__ void tred8(float (&p)[8], int lane) {
    const bool b3 = (lane & 8) != 0, b4 = (lane & 16) != 0, b5 = (lane & 32) != 0;
#pragma unroll
    for (int i = 0; i < 4; ++i) { const float send = b5 ? p[i] : p[i + 4], keep = b5 ? p[i + 4] : p[i]; p[i] = keep + __shfl_xor(send, 32); }
#pragma unroll
    for (int i = 0; i < 2; ++i) { const float send = b4 ? p[i] : p[i + 2], keep = b4 ? p[i + 2] : p[i]; p[i] = keep + __shfl_xor(send, 16); }
    { const float send = b3 ? p[0] : p[1], keep = b3 ? p[1] : p[0]; p[0] = keep + __shfl_xor(send, 8); }
    p[0] += __shfl_xor(p[0], 4); p[0] += __shfl_xor(p[0], 2); p[0] += __shfl_xor(p[0], 1);
}
__device__ __forceinline__ float fexp(float x) { return __builtin_amdgcn_exp2f(x * LOG2E); }
__device__ __forceinline__ float rdl_f(float v, int l) { return __builtin_bit_cast(float, __builtin_amdgcn_readlane(__builtin_bit_cast(int, v), l)); }
__device__ __forceinline__ void p7_router(Frame& F0, const float* const* in, const bf16* h2, unsigned char* ws) {
    Frame F = F0; refresh(F);
    const int gw = F.vcu * NWAVES + F.wave, NGW = F.G * NWAVES;
    LAS float* wet = (LAS float*)(F.lds + RING_OFF);
    const float* we = in[25];
    for (int i = F.tid; i < 32768; i += NWAVES * 64) { const int k = i >> 5, e = i & 31; wet[e * 1024 + k] = we[i]; }
    f32x4 wgv[4][4], gn[4];
#pragma unroll
    for (int j = 0; j < 4; ++j) { gn[j] = ((const GAS f32x4*)in[22])[F.lane + 64 * j];
#pragma unroll
        for (int i = 0; i < 4; ++i) wgv[j][i] = ((const GAS f32x4*)in[23])[4 * (F.lane + 64 * j) + i]; }
    const float bg0 = in[24][0], bg1 = in[24][1], bg2 = in[24][2], bg3 = in[24][3];
    unsigned* cnt = (unsigned*)(ws + WS_CTL) + CW_CNT; int* LIST = (int*)(ws + WS_LIST); float* GATE = (float*)(ws + WS_GATE); float* RSTD = (float*)(ws + WS_RSTD); int* TOKPOS = (int*)(ws + WS_TOKPOS);
    __syncthreads();
    v2u xw[4];
    if (gw < T) {
#pragma unroll
        for (int j = 0; j < 4; ++j) xw[j] = ((const GAS v2u*)(h2 + (size_t)gw * D) + F.lane)[64 * j]; }
    int pm_ = -1, pl0 = 0, pl1 = 0; unsigned pp0 = 0, pp1 = 0; float pgt0 = 0.f, pgt1 = 0.f, prs = 0.f;
    for (int m = gw; m < T; m += NGW) {
        f32x4 v[4]; float p[8];
#pragma unroll
        for (int i = 0; i < 8; ++i) p[i] = 0.f;
#pragma unroll
        for (int j = 0; j < 4; ++j) { const v2u w = xw[j]; v[j] = (f32x4){__builtin_bit_cast(float, w.x << 16), __builtin_bit_cast(float, w.x & 0xffff0000u), __builtin_bit_cast(float, w.y << 16), __builtin_bit_cast(float, w.y & 0xffff0000u)}; }
        if (m + NGW < T) {
#pragma unroll
            for (int j = 0; j < 4; ++j) xw[j] = ((const GAS v2u*)(h2 + (size_t)(m + NGW) * D) + F.lane)[64 * j]; }
#pragma unroll
        for (int j = 0; j < 4; ++j) {
            p[0] += (v[j].x * v[j].x + v[j].y * v[j].y) + (v[j].z * v[j].z + v[j].w * v[j].w);
            v[j] = v[j] * gn[j];
#pragma unroll
            for (int i = 0; i < 4; ++i) { const float xv = v[j][i]; p[1] += xv * wgv[j][i][0]; p[2] += xv * wgv[j][i][1]; p[3] += xv * wgv[j][i][2]; p[4] += xv * wgv[j][i][3]; } }
        tred8(p, F.lane);
        const float ssq = rdl_f(p[0], 0), rstd = rsqrtf(ssq * (1.f / D) + EPS);
        const float lg0 = rdl_f(p[0], 8) * rstd + bg0, lg1 = rdl_f(p[0], 16) * rstd + bg1, lg2 = rdl_f(p[0], 24) * rstd + bg2, lg3 = rdl_f(p[0], 32) * rstd + bg3;
        int gs = 0; float gm = lg0;
        if (lg1 > gm) { gm = lg1; gs = 1; } if (lg2 > gm) { gm = lg2; gs = 2; } if (lg3 > gm) { gm = lg3; gs = 3; }
        const float pg = __builtin_amdgcn_rcpf((fexp(lg0 - gm) + fexp(lg1 - gm)) + (fexp(lg2 - gm) + fexp(lg3 - gm)));
        gs = __builtin_amdgcn_readfirstlane(gs);
        float el[8];
#pragma unroll
        for (int c = 0; c < 8; ++c) { const LAS float* wc_ = wet + (gs * 8 + c) * 1024; float a = 0.f;
#pragma unroll
            for (int j = 0; j < 4; ++j) { const f32x4 w = *(const LAS f32x4*)(wc_ + 4 * (F.lane + 64 * j)); a += (v[j].x * w.x + v[j].y * w.y) + (v[j].z * w.z + v[j].w * w.w); }
            el[c] = a; }
        tred8(el, F.lane);
        { const float t = el[0];
#pragma unroll
          for (int c = 0; c < 8; ++c) el[c] = rdl_f(t, 8 * c) * rstd + in[26][gs * 8 + c]; }
        if (F.lane == 0) {
            float em = el[0];
#pragma unroll
            for (int c = 1; c < 8; ++c) em = fmaxf(em, el[c]);
            float ed = 0.f;
#pragma unroll
            for (int c = 0; c < 8; ++c) { el[c] = fexp(el[c] - em); ed += el[c]; }
            { const float ied = __builtin_amdgcn_rcpf(ed);
#pragma unroll
              for (int c = 0; c < 8; ++c) el[c] *= ied; }
            float v0 = el[0]; int i0 = 0;
#pragma unroll
            for (int c = 1; c < 8; ++c) if (el[c] > v0) { v0 = el[c]; i0 = c; }
            float v1 = -1.f; int i1 = 0;
#pragma unroll
            for (int c = 0; c < 8; ++c) if (c != i0 && el[c] > v1) { v1 = el[c]; i1 = c; }
            const float sum2 = v0 + v1;
            if (pm_ >= 0) { LIST[(size_t)pl0 * CAP + pp0] = pm_; GATE[(size_t)pl0 * CAP + pp0] = pgt0; LIST[(size_t)pl1 * CAP + pp1] = pm_; GATE[(size_t)pl1 * CAP + pp1] = pgt1;
                RSTD[pm_] = prs; TOKPOS[2 * pm_] = pl0 * CAP + (int)pp0; TOKPOS[2 * pm_ + 1] = pl1 * CAP + (int)pp1; }
            pl0 = gs * 8 + i0; pl1 = gs * 8 + i1;
            pp0 = atomicAdd(cnt + 64 * pl0, 1u); pp1 = atomicAdd(cnt + 64 * pl1, 1u);
            { const float is2 = pg * __builtin_amdgcn_rcpf(sum2); pgt0 = v0 * is2; pgt1 = v1 * is2; } prs = rstd; pm_ = m;
        }
    }
    if (F.lane == 0 && pm_ >= 0) { LIST[(size_t)pl0 * CAP + pp0] = pm_; GATE[(size_t)pl0 * CAP + pp0] = pgt0; LIST[(size_t)pl1 * CAP + pp1] = pm_; GATE[(size_t)pl1 * CAP + pp1] = pgt1;
        RSTD[pm_] = prs; TOKPOS[2 * pm_] = pl0 * CAP + (int)pp0; TOKPOS[2 * pm_ + 1] = pl1 * CAP + (int)pp1; }
}

struct EpiRouter {
    static constexpr bool PERM = false;
    const float* ssq; const float* bg; const float* be; unsigned* cnt; int* LIST; float* GATE; float* RSTD; int* TOKPOS; LAS float* xch; LAS unsigned* histl;
    __device__ __forceinline__ void operator()(const f32x4 (&acc)[2][2][4][2], const OrderMN::Unit& u, int wr, int wc, int fr, int fq) const {
        const size_t row0 = (size_t)u.pm * 256 + wr * 64 + fr;
        if (wc == 1 && fq == 0) {
            const float b0 = bg[0], b1 = bg[1], b2 = bg[2], b3 = bg[3];
#pragma unroll
            for (int ai = 0; ai < 2; ++ai)
#pragma unroll
                for (int m = 0; m < 4; ++m) { const f32x4 q = *(const f32x4*)(ssq + (row0 + ai * 128 + m * 16) * 4);
                    const float rstd = rsqrtf(((q[0] + q[1]) + (q[2] + q[3])) * (1.f / D) + EPS);
                    const f32x4 lg = (acc[ai][0][m][0] + acc[ai][1][m][0]) * rstd + (f32x4){b0, b1, b2, b3};
                    int gs = 0; float gm = lg[0];
                    if (lg[1] > gm) { gm = lg[1]; gs = 1; } if (lg[2] > gm) { gm = lg[2]; gs = 2; } if (lg[3] > gm) { gm = lg[3]; gs = 3; }
                    const float pg = __builtin_amdgcn_rcpf((fexp(lg[0] - gm) + fexp(lg[1] - gm)) + (fexp(lg[2] - gm) + fexp(lg[3] - gm)));
                    *(LAS f32x4*)(xch + (ai * 128 + wr * 64 + m * 16 + fr) * 4) = (f32x4){__builtin_bit_cast(float, gs), pg, rstd, 0.f}; } }
        if (wr == 0 && wc == 0) { const int e_ = fr + 16 * fq; if (e_ < 32) histl[e_] = 0u; }
        asm volatile("s_waitcnt lgkmcnt(0)" ::: "memory"); __builtin_amdgcn_s_barrier(); asm volatile("" ::: "memory");
        LAS unsigned* hist = histl;
        if (wc == 0) {
            unsigned lsel[8], lpos[8]; float g0a[8], g1a[8]; bool own[8];
#pragma unroll
            for (int ai = 0; ai < 2; ++ai)
#pragma unroll
                for (int m = 0; m < 4; ++m) { const int it = ai * 4 + m; const int rl = ai * 128 + wr * 64 + m * 16 + fr; const f32x4 gi = *(const LAS f32x4*)(xch + rl * 4);
                    const int gs = __builtin_bit_cast(int, gi[0]); const float pg = gi[1], rstd = gi[2];
                    const f32x4 a0 = acc[ai][0][m][0] + acc[ai][1][m][0], a1 = acc[ai][0][m][1] + acc[ai][1][m][1];
                    f32x4 mine;
#pragma unroll
                    for (int i = 0; i < 4; ++i) mine[i] = (gs >> 1) ? a1[i] : a0[i];
                    f32x4 other;
#pragma unroll
                    for (int i = 0; i < 4; ++i) other[i] = __shfl_xor(mine[i], 16);
                    own[it] = (fq == 2 * (gs & 1)); lsel[it] = 0u; lpos[it] = 0u; g0a[it] = 0.f; g1a[it] = 0.f;
                    if (own[it]) {
                        float el[8];
#pragma unroll
                        for (int i = 0; i < 4; ++i) { el[i] = mine[i] * rstd + be[gs * 8 + i]; el[4 + i] = other[i] * rstd + be[gs * 8 + 4 + i]; }
                        float em = el[0];
#pragma unroll
                        for (int c = 1; c < 8; ++c) em = fmaxf(em, el[c]);
                        float ed = 0.f;
#pragma unroll
                        for (int c = 0; c < 8; ++c) { el[c] = fexp(el[c] - em); ed += el[c]; }
                        { const float ied = __builtin_amdgcn_rcpf(ed);
#pragma unroll
                          for (int c = 0; c < 8; ++c) el[c] *= ied; }
                        float v0 = el[0]; int i0 = 0;
#pragma unroll
                        for (int c = 1; c < 8; ++c) if (el[c] > v0) { v0 = el[c]; i0 = c; }
                        float v1 = -1.f; int i1 = 0;
#pragma unroll
                        for (int c = 0; c < 8; ++c) if (c != i0 && el[c] > v1) { v1 = el[c]; i1 = c; }
                        const float is2 = pg * __builtin_amdgcn_rcpf(v0 + v1);
                        const unsigned l0 = (unsigned)(gs * 8 + i0), l1 = (unsigned)(gs * 8 + i1);
                        g0a[it] = v0 * is2; g1a[it] = v1 * is2; lsel[it] = l0 | (l1 << 8);
                        const unsigned r0 = __hip_atomic_fetch_add(hist + l0, 1u, __ATOMIC_RELAXED, __HIP_MEMORY_SCOPE_WORKGROUP), r1 = __hip_atomic_fetch_add(hist + l1, 1u, __ATOMIC_RELAXED, __HIP_MEMORY_SCOPE_WORKGROUP);
                        lpos[it] = r0 | (r1 << 16);
                    } }
            asm volatile("s_waitcnt lgkmcnt(0)" ::: "memory"); __builtin_amdgcn_s_barrier(); asm volatile("" ::: "memory");
            if (wr == 0) { const int e = fr + 16 * fq; if (e < 32) { const unsigned c = hist[e]; hist[32 + e] = c ? atomicAdd(cnt + 64 * e, c) : 0u; } }
            asm volatile("s_waitcnt vmcnt(0) lgkmcnt(0)" ::: "memory"); __builtin_amdgcn_s_barrier(); asm volatile("" ::: "memory");
#pragma unroll
            for (int it = 0; it < 8; ++it) if (own[it]) { const int ai = it >> 2, m = it & 3; const int tok = (int)(u.pm * 256 + ai * 128 + wr * 64 + m * 16 + fr);
                const unsigned l0 = lsel[it] & 255u, l1 = lsel[it] >> 8, p0 = hist[32 + l0] + (lpos[it] & 0xffffu), p1 = hist[32 + l1] + (lpos[it] >> 16);
                LIST[(size_t)l0 * CAP + p0] = tok; GATE[(size_t)l0 * CAP + p0] = g0a[it];
                LIST[(size_t)l1 * CAP + p1] = tok; GATE[(size_t)l1 * CAP + p1] = g1a[it];
                TOKPOS[2 * tok] = (int)(l0 * CAP + p0); TOKPOS[2 * tok + 1] = (int)(l1 * CAP + p1); }
        } else {
            asm volatile("s_waitcnt lgkmcnt(0)" ::: "memory"); __builtin_amdgcn_s_barrier(); asm volatile("" ::: "memory");
            asm volatile("s_waitcnt vmcnt(0) lgkmcnt(0)" ::: "memory"); __builtin_amdgcn_s_barrier(); asm volatile("" ::: "memory");
        }
    }
};

__device__ __forceinline__ void moe_table(Frame& F, const unsigned char* ws) {
    LAS int* tab = (LAS int*)(F.lds + TAB_OFF);
    int t_ = my_tid(); asm volatile("" : "+v"(t_));
    if (t_ < 64) {
        const unsigned* cnt = (const unsigned*)(ws + WS_CTL) + CW_CNT;
        const int c = (t_ < 32) ? (int)__hip_atomic_load(cnt + 64 * t_, RLX_AGENT) : 0;
        const int tiles = (c + 255) >> 8; int incl = tiles;
#pragma unroll
        for (int off = 1; off < 32; off <<= 1) { const int t = __shfl_up(incl, off); if (t_ >= off) incl += t; }
        if (t_ < 32) { tab[t_] = incl - tiles; tab[65 + t_] = c; }
        if (t_ == 31) tab[32] = incl;
    }
    __syncthreads();
}
struct OrderMoe {
    struct Unit { int l, rt, ct, grt; };
    const LAS int* tab; int l0, l1;
    const char* A; const char* B; size_t bstride  ; int lda, ldb; const int* LIST; int G, c; bool gather;
    __device__ __forceinline__ bool next(int i, Unit& u) const {
        const LAS int* tab = this->tab; asm volatile("" : "+s"(tab));
        const int L = i * G + c, t0 = __builtin_amdgcn_readfirstlane(tab[l0]), nun = (__builtin_amdgcn_readfirstlane(tab[l1]) - t0) * 4; if (L >= nun) return false;
        const int g = t0 + (L >> 2); int l = l0, hi_ = l1 - 1;
        while (l < hi_) { const int mid = (l + hi_ + 1) >> 1; if (__builtin_amdgcn_readfirstlane(tab[mid]) <= g) l = mid; else hi_ = mid - 1; }
        u.l = l; u.rt = g - __builtin_amdgcn_readfirstlane(tab[l]); u.ct = L & 3; u.grt = g; return true;
    }
    __device__ __forceinline__ const char* pa(const Unit& u) const { return gather ? A : A + (size_t)u.grt * 256 * lda; }
    __device__ __forceinline__ const char* pb(const Unit& u) const { return B + (size_t)(u.l & 31) * bstride + (size_t)u.ct * 256 * ldb; }
    __device__ __forceinline__ const int* idx(const Unit& u) const { return LIST + (size_t)u.l * CAP + u.rt * 256; }
};
struct EpiGU {
    static constexpr bool PERM = true;
    bf16* HID; const int* LIST; const float* RSTD; const float* SBGU; LAS float* xl;
#define EG_X(ai, bj, m, n) (acc[ai][bj][m][n] * (sbv[bj][n] * rs))
    using Pre = int;
    __device__ __forceinline__ void prefetch(const OrderMoe::Unit& u, int wr, int wid, int lane, const LAS int* idx) const {
        int tk[2];
        if (idx) { tk[0] = idx[wr * 64 + lane]; tk[1] = idx[128 + wr * 64 + lane]; }
        else { const int* lp = LIST + (size_t)u.l * CAP + u.rt * 256 + wr * 64 + lane; tk[0] = lp[0]; tk[1] = lp[128]; }
#pragma unroll
        for (int ai = 0; ai < 2; ++ai) __builtin_amdgcn_global_load_lds((const unsigned*)(RSTD + tk[ai]), (LAS unsigned*)(xl + wid * 128 + ai * 64), 4, 0, 0);
    }
    __device__ __forceinline__ void operator()(const f32x4 (&acc)[2][2][4][2], const OrderMoe::Unit& u, int wr, int wc, int fr, int fq) const {
        f32x4 sbv[2][2];
#pragma unroll
        for (int bj = 0; bj < 2; ++bj)
#pragma unroll
            for (int n = 0; n < 2; ++n) sbv[bj][n] = *(const f32x4*)(SBGU + (size_t)(u.l & 31) * 1024 + u.ct * 256 + 128 * bj + 32 * wc + 8 * fq + 4 * n);
        ST8X_ROLE();
        unsigned char* dst = (unsigned char*)HID + ((size_t)u.grt * 256 + wr * 64 + fr2) * 512 + u.ct * 128 + wc * 32 + 8 * fq2;
        float rs8[8];
#pragma unroll
        for (int it = 0; it < 8; ++it) rs8[it] = xl[(wr * 4 + wc) * 128 + (it >> 2) * 64 + (it & 3) * 16 + fr];
#pragma unroll
        for (int ai = 0; ai < 2; ++ai) {
#pragma unroll
            for (int m = 0; m < 4; ++m) { const float rs = rs8[ai * 4 + m];
                f32x4 h0, h1; const f32x4 g0 = EG_X(ai, 0, m, 0), g1 = EG_X(ai, 0, m, 1), u0 = EG_X(ai, 1, m, 0), u1 = EG_X(ai, 1, m, 1);
#pragma unroll
                for (int i = 0; i < 4; ++i) { h0[i] = silu_f(g0[i]) * u0[i]; h1[i] = silu_f(g1[i]) * u1[i]; }
                { v2u w_; w_.x = pack_fp8x4(h0[0], h0[1], h0[2], h0[3]); w_.y = pack_fp8x4(h1[0], h1[1], h1[2], h1[3]);
                  v2u o_; o_.x = (unsigned)__builtin_amdgcn_ds_bpermute(pull4, (int)w_.x); o_.y = (unsigned)__builtin_amdgcn_ds_bpermute(pull4, (int)w_.y);
                  *(v2u*)(dst + (size_t)(ai * 128 + m * 16) * 512) = o_; } }
            asm volatile("" ::: "memory"); }
    }
};
#undef EG_X
struct EpiY {
    static constexpr bool PERM = true;
    bf16* Y; const float* GATE; const unsigned char* wsb;
    __device__ __forceinline__ void operator()(const f32x4 (&acc)[2][2][4][2], const OrderMoe::Unit& u, int wr, int wc, int fr, int fq) const {
        const float* gp = GATE + (size_t)u.l * CAP + u.rt * 256 + wr * 64 + fr;
        ST8X_ROLE();
        const __amdgpu_buffer_rsrc_t rs_ = __builtin_amdgcn_make_buffer_rsrc((void*)wsb, 0, 0xffffffff, 0x00020000);
        const unsigned so_ = (unsigned)((const unsigned char*)Y - wsb) + (unsigned)u.grt * (256u * 2048u) + (unsigned)u.ct * 512u;
        const unsigned vo_ = (unsigned)(wr * 64 + fr2) * 2048u + (unsigned)(wc * 32 + 8 * fq2) * 2u;
        float gv8[8];
#pragma unroll
        for (int it = 0; it < 8; ++it) gv8[it] = gp[(it >> 2) * 128 + (it & 3) * 16];
#pragma unroll
        for (int ai = 0; ai < 2; ++ai)
#pragma unroll
            for (int m = 0; m < 4; ++m) { const float g = gv8[ai * 4 + m];
#pragma unroll
                for (int bj = 0; bj < 2; ++bj) { const f32x4 a_ = acc[ai][bj][m][0] * g, b_ = acc[ai][bj][m][1] * g;
                    v2u w_; w_.x = pk_fp8x4(a_[0], a_[1], a_[2], a_[3]); w_.y = pk_fp8x4(b_[0], b_[1], b_[2], b_[3]);
                    v2u o_; o_.x = (unsigned)__builtin_amdgcn_ds_bpermute(pull4, (int)w_.x); o_.y = (unsigned)__builtin_amdgcn_ds_bpermute(pull4, (int)w_.y);
                    *(v2u*)((unsigned char*)Y + ((size_t)u.grt * 256 + wr * 64 + fr2 + ai * 128 + m * 16) * 1024 + u.ct * 256 + wc * 32 + 8 * fq2 + 128 * bj) = o_; }
                asm volatile("" ::: "memory"); }
    }
};
__device__ __forceinline__ void p10_combine(Frame& F0, const bf16* H2B, const bf16* Y, float* out, const unsigned char* ws) {
    Frame F = F0; refresh(F);
    const int gw = F.vcu * NWAVES + F.wave, NGW = F.G * NWAVES;
    const LAS int* tab = (const LAS int*)(F.lds + TAB_OFF); const int* TOKPOS = (const int*)(ws + WS_TOKPOS);
    for (int m = gw; m < T; m += NGW) {
        const int t0 = TOKPOS[2 * m], t1 = TOKPOS[2 * m + 1];
        const size_t r0 = (size_t)256 * tab[t0 >> 15] + (t0 & (CAP - 1)), r1 = (size_t)256 * tab[t1 >> 15] + (t1 & (CAP - 1));
        const GAS v4u* hp = (const GAS v4u*)(H2B + (size_t)m * D) + F.lane; const GAS v2u* y0 = (const GAS v2u*)((const unsigned char*)Y + r0 * D) + F.lane; const GAS v2u* y1 = (const GAS v2u*)((const unsigned char*)Y + r1 * D) + F.lane;
        GAS f32x4* op = (GAS f32x4*)(out + (size_t)m * D) + 2 * F.lane;
#pragma unroll
        for (int jj = 0; jj < 2; ++jj) { const v4u a = hp[64 * jj]; const v2u b = y0[64 * jj], c = y1[64 * jj]; f32x4 o0, o1;
            const f32x2_t b0 = __builtin_amdgcn_cvt_pk_f32_fp8((int)b.x, false), b1 = __builtin_amdgcn_cvt_pk_f32_fp8((int)b.x, true), b2 = __builtin_amdgcn_cvt_pk_f32_fp8((int)b.y, false), b3 = __builtin_amdgcn_cvt_pk_f32_fp8((int)b.y, true);
            const f32x2_t c0 = __builtin_amdgcn_cvt_pk_f32_fp8((int)c.x, false), c1 = __builtin_amdgcn_cvt_pk_f32_fp8((int)c.x, true), c2 = __builtin_amdgcn_cvt_pk_f32_fp8((int)c.y, false), c3 = __builtin_amdgcn_cvt_pk_f32_fp8((int)c.y, true);
            const f32x2_t ys[4] = {(b0 + c0) * 0.0625f, (b1 + c1) * 0.0625f, (b2 + c2) * 0.0625f, (b3 + c3) * 0.0625f};
#pragma unroll
            for (int i = 0; i < 2; ++i) {
                o0[2 * i] = __builtin_bit_cast(float, a[i] << 16) + ys[i].x;
                o0[2 * i + 1] = __builtin_bit_cast(float, a[i] & 0xffff0000u) + ys[i].y;
                o1[2 * i] = __builtin_bit_cast(float, a[2 + i] << 16) + ys[2 + i].x;
                o1[2 * i + 1] = __builtin_bit_cast(float, a[2 + i] & 0xffff0000u) + ys[2 + i].y; }
            op[128 * jj] = o0; op[128 * jj + 1] = o1; }
    }
}

namespace da {
constexpr int STG = 32768, XOFF = 65536;
typedef short s16x4 __attribute__((ext_vector_type(4)));
typedef short v4i16_t __attribute__((ext_vector_type(4)));
__device__ __forceinline__ s16x4 vtr(const LAS unsigned char* p) { return __builtin_bit_cast(s16x4, __builtin_amdgcn_ds_read_tr16_b64_v4i16((LAS v4i16_t*)p)); }
__device__ __forceinline__ float hswap_max(float m) { auto rr = __builtin_amdgcn_permlane32_swap(__float_as_uint(m), __float_as_uint(m), false, false); return fmaxf(__uint_as_float(rr[0]), __uint_as_float(rr[1])); }
__device__ __forceinline__ float hswap_sum(float m) { auto rr = __builtin_amdgcn_permlane32_swap(__float_as_uint(m), __float_as_uint(m), false, false); return __uint_as_float(rr[0]) + __uint_as_float(rr[1]); }
#define DA_BAR() asm volatile("s_waitcnt vmcnt(0) lgkmcnt(0)\n\ts_barrier" ::: "memory")

__device__ __forceinline__ void unit(LAS unsigned char* lds, LAS float* wsf_all, int b, int h, int qb, const bf16* __restrict__ DQ, const bf16* __restrict__ DK, const bf16* __restrict__ DV, bf16* MIX, float lam, const float* __restrict__ on_gain) {
    int tid_ = my_tid(); asm volatile("" : "+v"(tid_));
    const int tid = tid_, lane = tid & 63, r32 = lane & 31, hi = lane >> 5; const int wid = __builtin_amdgcn_readfirstlane(tid >> 6);
    const int sm = wid >> 2, rb = wid & 3;
    const size_t rowbase = (size_t)b * SEQ;
    const int q0 = qb * 128 + rb * 32, cw = q0 >> 6, NT = 2 * qb + 2;
    LAS float* wsf = wsf_all + wid * 64;
    bf16x8 qr[4];
    { const bf16* Qw = DQ + (rowbase + q0 + r32) * 512 + h * 128 + sm * 64 + hi * 8;
#pragma unroll
      for (int d0 = 0; d0 < 4; ++d0) qr[d0] = *(const bf16x8*)(Qw + d0 * 16); }
    const bf16* k1src = DK + (rowbase + lane) * 512 + h * 128 + wid * 8;
    const bf16* v0src = DV + (rowbase + 16 * (wid & 3) + (lane >> 2)) * 512 + h * 128 + (wid >> 2) * 32 + (lane & 3) * 8;
#define DA_DMA(j, st) do { LAS unsigned char* sb_ = lds + (st) * STG; const size_t go_ = (size_t)(j) * 64 * 512; \
        __builtin_amdgcn_global_load_lds((const unsigned*)(k1src + go_), (LAS unsigned*)(sb_ + wid * 1024), 16, 0, 0); \
        __builtin_amdgcn_global_load_lds((const unsigned*)(k1src + go_ + 64), (LAS unsigned*)(sb_ + 8192 + wid * 1024), 16, 0, 0); \
        __builtin_amdgcn_global_load_lds((const unsigned*)(v0src + go_), (LAS unsigned*)(sb_ + 16384 + wid * 1024), 16, 0, 0); \
        __builtin_amdgcn_global_load_lds((const unsigned*)(v0src + go_ + 64), (LAS unsigned*)(sb_ + 16384 + (wid + 8) * 1024), 16, 0, 0); } while (0)
    float m = -1e30f, l = 0.f;
    f32x16 o[4];
#pragma unroll
    for (int i = 0; i < 4; ++i) o[i] = f32x16{};
    DA_DMA(0, 0);
    for (int j = 0; j < NT; ++j) {
        DA_BAR();
        if (j + 1 < NT) DA_DMA(j + 1, (j + 1) & 1);
        if (j <= cw) {
            const LAS unsigned char* sb = lds + (j & 1) * STG;
            const LAS unsigned char* kb = sb + sm * 8192 + hi * 1024 + r32 * 16;
            bf16x8 kf0[4], kf1[4];
#pragma unroll
            for (int d0 = 0; d0 < 4; ++d0) { kf0[d0] = *(const LAS bf16x8*)(kb + d0 * 2048); kf1[d0] = *(const LAS bf16x8*)(kb + d0 * 2048 + 512); }
            const LAS unsigned char* vp = sb + 16384 + ((lane >> 4) & 1) * 32 + (lane & 3) * 8 + (4 * hi + ((lane & 15) >> 2)) * 64;
            s16x4 vl[2][4], vh[2][4];
#pragma unroll
            for (int blk = 0; blk < 4; ++blk) { vl[0][blk] = vtr(vp + (blk * 4) * 1024); vh[0][blk] = vtr(vp + (blk * 4) * 1024 + 512); }
            f32x16 p0 = f32x16{}, p1 = f32x16{};
#pragma unroll
            for (int d0 = 0; d0 < 4; ++d0) {
                p0 = __builtin_amdgcn_mfma_f32_32x32x16_bf16(kf0[d0], qr[d0], p0, 0, 0, 0);
                p1 = __builtin_amdgcn_mfma_f32_32x32x16_bf16(kf1[d0], qr[d0], p1, 0, 0, 0);
            }
            float tm = fmaxf(p0[0], p1[0]);
#pragma unroll
            for (int r = 1; r < 16; ++r) tm = fmaxf(tm, fmaxf(p0[r], p1[r]));
            tm = hswap_max(tm);
            if (__any(tm > m + 8.f)) {
                const float mn = fmaxf(m, tm), alpha = __builtin_amdgcn_exp2f(m - mn); m = mn;
                l *= alpha;
                if (hi == 0) wsf[r32] = alpha;
                asm volatile("s_waitcnt lgkmcnt(0)" ::: "memory");
#pragma unroll
                for (int g = 0; g < 4; ++g) { const f32x4 a4 = *(const LAS f32x4*)(wsf + 8 * g + 4 * hi);
#pragma unroll
                    for (int blk = 0; blk < 4; ++blk)
#pragma unroll
                        for (int i = 0; i < 4; ++i) o[blk][4 * g + i] *= a4[i]; }
            }
            float rs = 0.f;
#pragma unroll
            for (int r = 0; r < 16; ++r) { p0[r] = __builtin_amdgcn_exp2f(p0[r] - m); p1[r] = __builtin_amdgcn_exp2f(p1[r] - m); rs += p0[r] + p1[r]; }
            l += rs;
            v4u pw[4];
#pragma unroll
            for (int i = 0; i < 4; ++i) { pw[0][i] = cvtpk_s(p0[2 * i], p0[2 * i + 1]); pw[1][i] = cvtpk_s(p0[8 + 2 * i], p0[9 + 2 * i]); pw[2][i] = cvtpk_s(p1[2 * i], p1[2 * i + 1]); pw[3][i] = cvtpk_s(p1[8 + 2 * i], p1[9 + 2 * i]); }
#pragma unroll
            for (int s = 0; s < 4; ++s) {
                if (s < 3) {
#pragma unroll
                    for (int blk = 0; blk < 4; ++blk) { vl[(s + 1) & 1][blk] = vtr(vp + (blk * 4 + s + 1) * 1024); vh[(s + 1) & 1][blk] = vtr(vp + (blk * 4 + s + 1) * 1024 + 512); } }
#pragma unroll
                for (int blk = 0; blk < 4; ++blk) { const s16x4 lo = vl[s & 1][blk], hh = vh[s & 1][blk];
                    o[blk] = __builtin_amdgcn_mfma_f32_32x32x16_bf16(__builtin_bit_cast(bf16x8, pw[s]), (bf16x8){lo[0], lo[1], lo[2], lo[3], hh[0], hh[1], hh[2], hh[3]}, o[blk], 0, 0, 0); }
            }
        }
    }
    l = hswap_sum(l);
    { const float inv = (sm ? lam : 1.f) / l;
      if (hi == 0) wsf[r32] = inv;
      asm volatile("s_waitcnt lgkmcnt(0)" ::: "memory");
#pragma unroll
      for (int g = 0; g < 4; ++g) { const f32x4 a4 = *(const LAS f32x4*)(wsf + 8 * g + 4 * hi);
#pragma unroll
          for (int blk = 0; blk < 4; ++blk)
#pragma unroll
              for (int i = 0; i < 4; ++i) o[blk][4 * g + i] *= a4[i]; } }
    LAS float* X = (LAS float*)(lds + XOFF) + rb * 4096;
    if (sm == 1) {
#pragma unroll
        for (int blk = 0; blk < 4; ++blk)
#pragma unroll
            for (int r = 0; r < 16; ++r) X[((r & 3) + 8 * (r >> 2) + 4 * hi) * 128 + blk * 32 + r32] = o[blk][r];
    }
    DA_BAR();
    if (sm == 0) {
#pragma unroll
        for (int blk = 0; blk < 4; ++blk)
#pragma unroll
            for (int r = 0; r < 16; ++r) { LAS float* xp = X + ((r & 3) + 8 * (r >> 2) + 4 * hi) * 128 + blk * 32 + r32; *xp = o[blk][r] - *xp; }
        asm volatile("s_waitcnt lgkmcnt(0)" ::: "memory");
        const int q = lane >> 1, half = lane & 1;
        const LAS f32x4* xr = (const LAS f32x4*)(X + q * 128 + half * 64);
        f32x4 v[16]; float ss = 0.f;
#pragma unroll
        for (int i = 0; i < 16; ++i) { v[i] = xr[i]; ss += (v[i][0] * v[i][0] + v[i][1] * v[i][1]) + (v[i][2] * v[i][2] + v[i][3] * v[i][3]); }
        ss += __shfl_xor(ss, 1);
        const float rstd = rsqrtf(ss * (1.f / 128.f) + EPS) * (1.f - LAM_INIT);
        bf16* op = MIX + (rowbase + q0 + q) * 1024 + h * 128 + half * 64;
#pragma unroll
        for (int i = 0; i < 8; ++i) { const f32x4 g0 = *(const f32x4*)(on_gain + half * 64 + 8 * i), g1 = *(const f32x4*)(on_gain + half * 64 + 8 * i + 4);
            st8(op + 8 * i, v[2 * i] * rstd * g0, v[2 * i + 1] * rstd * g1); }
    }
    DA_BAR();
#undef DA_DMA
}
}

namespace da2 {
using da::s16x4; using da::vtr; using da::hswap_max; using da::hswap_sum;
constexpr int SLK = 16384, SLV = 16384, L_K = 0, L_V = 65536, XOFF = 0;
#define D2_SBAR() __builtin_amdgcn_sched_barrier(0)
#define D2_PIN(x) asm volatile("" : "+v"(x))
#define D2_WAIT_BAR(N) asm volatile("s_waitcnt vmcnt(" #N ") lgkmcnt(0)\n\ts_barrier" ::: "memory")
#define D2_MFMA(a, b, c) __builtin_amdgcn_mfma_f32_32x32x16_bf16(a, b, c, 0, 0, 0)
#define D2_MX3(a, b, c) __builtin_fmaxf(__builtin_fmaxf((a), (b)), (c))
__device__ __forceinline__ float rowmax(const f32x16& p0, const f32x16& p1) {
    float a = D2_MX3(p0[0], p0[1], p1[0]), b = D2_MX3(p0[2], p0[3], p1[1]); a = D2_MX3(a, p1[2], p1[3]);
#pragma unroll
    for (int r = 4; r < 16; r += 4) { a = D2_MX3(a, p0[r], p0[r + 1]); b = D2_MX3(b, p0[r + 2], p0[r + 3]); a = D2_MX3(a, p1[r], p1[r + 1]); b = D2_MX3(b, p1[r + 2], p1[r + 3]); }
    return hswap_max(__builtin_fmaxf(a, b)); }

template <bool FAST>
__device__ __forceinline__ void unit(LAS unsigned char* lds, LAS float* wsf_all, int b, int h, int qb, const bf16* __restrict__ DQ, const bf16* __restrict__ DK, const bf16* __restrict__ DV, bf16* MIX, float lam, const float* __restrict__ on_gain,
                                     unsigned* qctr, volatile LAS unsigned* qslot) {
    int tid_ = my_tid(); asm volatile("" : "+v"(tid_));
    const int tid = tid_, lane = tid & 63, r32 = lane & 31, hi = lane >> 5; const int wid = __builtin_amdgcn_readfirstlane(tid >> 6);
    const int sm = wid >> 2, rb = wid & 3;
    const size_t rowbase = (size_t)b * SEQ;
    const int q0 = qb * 128 + rb * 32, NT = 2 * qb + 2; const bool full_last = rb >= 2;
    LAS float* wsf = wsf_all + wid * 64;
    bf16x8 qr[4];
    { const bf16* Qw = DQ + (rowbase + q0 + r32) * 512 + h * 128 + sm * 64 + hi * 8;
#pragma unroll
      for (int d0 = 0; d0 < 4; ++d0) qr[d0] = *(const bf16x8*)(Qw + d0 * 16); }
    const bf16* k1src = DK + ((size_t)((b * 4 + h) * 64)) * 8192 + wid * 512 + lane * 8;
    const bf16* v0src = DV + ((size_t)((b * 4 + h) * 64)) * 8192 + wid * 512 + lane * 8;
#define D2_DMA_K(t_, so_) do { const size_t go_ = (size_t)(t_) * 8192; LAS unsigned char* d_ = lds + L_K + (so_) + wid * 1024; \
        __builtin_amdgcn_global_load_lds((const unsigned*)(k1src + go_), (LAS unsigned*)d_, 16, 0, 0); \
        __builtin_amdgcn_global_load_lds((const unsigned*)(k1src + go_ + 4096), (LAS unsigned*)(d_ + 8192), 16, 0, 0); } while (0)
#define D2_DMA_V(t_, so_) do { const size_t go_ = (size_t)(t_) * 8192; LAS unsigned char* d_ = lds + L_V + (so_) + wid * 1024; \
        __builtin_amdgcn_global_load_lds((const unsigned*)(v0src + go_), (LAS unsigned*)d_, 16, 0, 0); \
        __builtin_amdgcn_global_load_lds((const unsigned*)(v0src + go_ + 4096), (LAS unsigned*)(d_ + 8192), 16, 0, 0); } while (0)
    const LAS unsigned char* kp0 = lds + L_K + sm * 8192 + hi * 1024 + r32 * 16;
    const LAS unsigned char* vp0 = lds + L_V + ((lane >> 4) & 1) * 32 + (lane & 3) * 8 + (4 * hi + ((lane & 15) >> 2)) * 64;
    float l = 0.f, m = 0.f; bool resc = false;
    f32x16 o[4];
#pragma unroll
    for (int i = 0; i < 4; ++i) o[i] = f32x16{};
    f32x16 pA0, pA1, pB0, pB1;
    bf16x8 kfr[4]; s16x4 vlo[4], vhi[4]; v4u pw[4];
    int vprev = 2 * SLV, vcur = 0, vnext = SLV;
#define D2_ROT() do { vprev = vcur; vcur = vnext; vnext = (vnext == 2 * SLV) ? 0 : vnext + SLV; } while (0)
#define D2_KF(kp_, i_) (*(const LAS bf16x8*)((kp_) + ((i_) >> 1) * 2048 + ((i_) & 1) * 512))
#define D2_VRD(vp_, slot_, j_) do { vlo[slot_] = vtr((vp_) + ((((j_) & 3) * 4 + ((j_) >> 2))) * 1024); vhi[slot_] = vtr((vp_) + ((((j_) & 3) * 4 + ((j_) >> 2))) * 1024 + 512); } while (0)
#define D2_VFR(slot_) (bf16x8){vlo[slot_][0], vlo[slot_][1], vlo[slot_][2], vlo[slot_][3], vhi[slot_][0], vhi[slot_][1], vhi[slot_][2], vhi[slot_][3]}
#define D2_PK(P, i_) cvtpk_s(P[i_], P[(i_) + 1])
#define D2_RESC() do { if (resc) { asm volatile("s_waitcnt lgkmcnt(0)" ::: "memory"); \
        _Pragma("unroll") for (int g_ = 0; g_ < 4; ++g_) { const f32x4 a4_ = *(const LAS f32x4*)(wsf + 8 * g_ + 4 * hi); \
            _Pragma("unroll") for (int blk_ = 0; blk_ < 4; ++blk_) _Pragma("unroll") for (int i_ = 0; i_ < 4; ++i_) o[blk_][4 * g_ + i_] *= a4_[i_]; } resc = false; } } while (0)
#define D2_CLOSE(t_) do { if ((t_) + 3 < NT) { D2_WAIT_BAR(4); } else if ((t_) + 1 < NT) { D2_WAIT_BAR(2); } else { D2_WAIT_BAR(0); } D2_RESC(); D2_ROT(); } while (0)
#define D2_ISSUE(t_) do { if ((t_) + 3 < NT) D2_DMA_K((t_) + 3, (((t_) + 3) & 3) * SLK); if ((t_) + 1 < NT) D2_DMA_V((t_) + 1, vnext); } while (0)
#define D2_GAPA(MF, RD, a0, a1, a2, a3, W0, W1, PWv) do { MF; RD; sacc += a0; sacc += a1; sacc += a2; sacc += a3; W0; W1; D2_PIN(PWv); D2_PIN(sacc); D2_SBAR(); } while (0)
#define D2_GAPB(MF, RD, X, i_) do { MF; RD; X[i_] = __builtin_amdgcn_exp2f(X[i_]); X[(i_) + 1] = __builtin_amdgcn_exp2f(X[(i_) + 1]); D2_PIN(X); D2_SBAR(); } while (0)
#define D2_SUMPACK(P0, P1) do { float sacc = 0.f; _Pragma("unroll") for (int r_ = 0; r_ < 16; ++r_) sacc += P0[r_] + P1[r_]; l += sacc; \
        _Pragma("unroll") for (int i_ = 0; i_ < 4; ++i_) { pw[0][i_] = D2_PK(P0, 2 * i_); pw[1][i_] = D2_PK(P0, 8 + 2 * i_); pw[2][i_] = D2_PK(P1, 2 * i_); pw[3][i_] = D2_PK(P1, 8 + 2 * i_); } } while (0)
#define D2_PHASEB(C0, C1, DOEXP, GL, kpn_) do { \
        D2_GAPB(o[0] = D2_MFMA(__builtin_bit_cast(bf16x8, pw[0]), D2_VFR(0), o[0]), D2_VRD(vp_, 0, 4),  C0, 0);  D2_GAPB(o[1] = D2_MFMA(__builtin_bit_cast(bf16x8, pw[0]), D2_VFR(1), o[1]), D2_VRD(vp_, 1, 5),  C0, 2); \
        D2_GAPB(o[2] = D2_MFMA(__builtin_bit_cast(bf16x8, pw[0]), D2_VFR(2), o[2]), D2_VRD(vp_, 2, 6),  C0, 4);  D2_GAPB(o[3] = D2_MFMA(__builtin_bit_cast(bf16x8, pw[0]), D2_VFR(3), o[3]), D2_VRD(vp_, 3, 7),  C0, 6); \
        D2_GAPB(o[0] = D2_MFMA(__builtin_bit_cast(bf16x8, pw[1]), D2_VFR(0), o[0]), D2_VRD(vp_, 0, 8),  C0, 8);  D2_GAPB(o[1] = D2_MFMA(__builtin_bit_cast(bf16x8, pw[1]), D2_VFR(1), o[1]), D2_VRD(vp_, 1, 9),  C0, 10); \
        D2_GAPB(o[2] = D2_MFMA(__builtin_bit_cast(bf16x8, pw[1]), D2_VFR(2), o[2]), D2_VRD(vp_, 2, 10), C0, 12); D2_GAPB(o[3] = D2_MFMA(__builtin_bit_cast(bf16x8, pw[1]), D2_VFR(3), o[3]), D2_VRD(vp_, 3, 11), C0, 14); \
        D2_GAPB(o[0] = D2_MFMA(__builtin_bit_cast(bf16x8, pw[2]), D2_VFR(0), o[0]), D2_VRD(vp_, 0, 12), C1, 0);  D2_GAPB(o[1] = D2_MFMA(__builtin_bit_cast(bf16x8, pw[2]), D2_VFR(1), o[1]), D2_VRD(vp_, 1, 13), C1, 2); \
        D2_GAPB(o[2] = D2_MFMA(__builtin_bit_cast(bf16x8, pw[2]), D2_VFR(2), o[2]), D2_VRD(vp_, 2, 14), C1, 4);  D2_GAPB(o[3] = D2_MFMA(__builtin_bit_cast(bf16x8, pw[2]), D2_VFR(3), o[3]), D2_VRD(vp_, 3, 15), C1, 6); \
        D2_GAPB(o[0] = D2_MFMA(__builtin_bit_cast(bf16x8, pw[3]), D2_VFR(0), o[0]), if (GL) kfr[0] = D2_KF(kpn_, 0), C1, 8);  D2_GAPB(o[1] = D2_MFMA(__builtin_bit_cast(bf16x8, pw[3]), D2_VFR(1), o[1]), if (GL) kfr[1] = D2_KF(kpn_, 1), C1, 10); \
        D2_GAPB(o[2] = D2_MFMA(__builtin_bit_cast(bf16x8, pw[3]), D2_VFR(2), o[2]), if (GL) kfr[2] = D2_KF(kpn_, 2), C1, 12); D2_GAPB(o[3] = D2_MFMA(__builtin_bit_cast(bf16x8, pw[3]), D2_VFR(3), o[3]), if (GL) kfr[3] = D2_KF(kpn_, 3), C1, 14); \
    } while (0)
#define D2_STEP(C0, C1, P0, P1, t_, GL) do { D2_SBAR(); \
        const LAS unsigned char* kp_ = kp0 + ((t_) & 3) * SLK; const LAS unsigned char* kpn_ = kp0 + (((t_) + 1) & 3) * SLK; const LAS unsigned char* vp_ = vp0 + vprev; \
        float sacc = P0[0] + P0[1]; \
        if constexpr (FAST) { C0 = f32x16{}; C1 = f32x16{}; } else \
        { const v2u on_ = {hi ? 0u : 0x3F80u, 0u}, qm_ = {hi ? 0u : (__builtin_bit_cast(unsigned, -m) >> 16), 0u};     \
          C0 = __builtin_amdgcn_mfma_f32_32x32x8bf16_1k(__builtin_bit_cast(s16x4, on_), __builtin_bit_cast(s16x4, qm_), (f32x16{}), 0, 0, 0); C1 = __builtin_amdgcn_mfma_f32_32x32x8bf16_1k(__builtin_bit_cast(s16x4, on_), __builtin_bit_cast(s16x4, qm_), (f32x16{}), 0, 0, 0); } \
        D2_GAPA(C0 = D2_MFMA(kfr[0], qr[0], C0), kfr[0] = D2_KF(kp_, 4), P0[2], P0[3], P0[4], P0[5],     pw[0][0] = D2_PK(P0, 0),  pw[0][1] = D2_PK(P0, 2),  pw[0]); \
        D2_GAPA(C1 = D2_MFMA(kfr[1], qr[0], C1), kfr[1] = D2_KF(kp_, 5), P0[6], P0[7], P0[8], P0[9],     pw[0][2] = D2_PK(P0, 4),  pw[0][3] = D2_PK(P0, 6),  pw[0]); \
        D2_GAPA(C0 = D2_MFMA(kfr[2], qr[1], C0),   kfr[2] = D2_KF(kp_, 6), P0[10], P0[11], P0[12], P0[13], pw[1][0] = D2_PK(P0, 8),  pw[1][1] = D2_PK(P0, 10), pw[1]); \
        D2_GAPA(C1 = D2_MFMA(kfr[3], qr[1], C1),   kfr[3] = D2_KF(kp_, 7), P0[14], P0[15], P1[0], P1[1],   pw[1][2] = D2_PK(P0, 12), pw[1][3] = D2_PK(P0, 14), pw[1]); \
        D2_GAPA(C0 = D2_MFMA(kfr[0], qr[2], C0),   D2_VRD(vp_, 0, 0),     P1[2], P1[3], P1[4], P1[5],     pw[2][0] = D2_PK(P1, 0),  pw[2][1] = D2_PK(P1, 2),  pw[2]); \
        D2_GAPA(C1 = D2_MFMA(kfr[1], qr[2], C1),   D2_VRD(vp_, 1, 1),     P1[6], P1[7], P1[8], P1[9],     pw[2][2] = D2_PK(P1, 4),  pw[2][3] = D2_PK(P1, 6),  pw[2]); \
        D2_GAPA(C0 = D2_MFMA(kfr[2], qr[3], C0),   D2_VRD(vp_, 2, 2),     P1[10], P1[11], P1[12], P1[13], pw[3][0] = D2_PK(P1, 8),  pw[3][1] = D2_PK(P1, 10), pw[3]); \
        D2_GAPA(C1 = D2_MFMA(kfr[3], qr[3], C1),   D2_VRD(vp_, 3, 3),     P1[14], P1[15], 0.f, 0.f,       pw[3][2] = D2_PK(P1, 12), pw[3][3] = D2_PK(P1, 14), pw[3]); \
        l += sacc; \
        D2_ISSUE(t_); \
        if constexpr (!FAST) { const float rm = rowmax(C0, C1);                                                \
          if (__builtin_expect(__any(rm > 8.f), 0)) { const float mn = bf2f(f2bf(m + __builtin_fmaxf(rm, 0.f))), d_ = mn - m, f = __builtin_amdgcn_exp2f(-d_); m = mn; l *= f; if (hi == 0) wsf[r32] = f; resc = true; \
              _Pragma("unroll") for (int r_ = 0; r_ < 16; ++r_) { C0[r_] -= d_; C1[r_] -= d_; } } } \
        D2_SBAR(); \
        D2_PHASEB(C0, C1, true, GL, kpn_); \
    } while (0)
#define D2_PVSTEP(P0, P1, t_) do { D2_SBAR(); const LAS unsigned char* vp_ = vp0 + vprev; \
        D2_VRD(vp_, 0, 0); D2_VRD(vp_, 1, 1); D2_VRD(vp_, 2, 2); D2_VRD(vp_, 3, 3); \
        D2_SUMPACK(P0, P1); D2_ISSUE(t_); \
        _Pragma("unroll") for (int j_ = 0; j_ < 16; ++j_) { o[j_ & 3] = D2_MFMA(__builtin_bit_cast(bf16x8, pw[j_ >> 2]), D2_VFR(j_ & 3), o[j_ & 3]); if (j_ + 4 < 16) D2_VRD(vp_, j_ & 3, j_ + 4); } \
    } while (0)

    D2_DMA_K(0, 0); D2_DMA_V(0, 0); D2_DMA_K(1, SLK);
    if (NT > 2) { D2_DMA_K(2, 2 * SLK); D2_WAIT_BAR(6); } else { D2_WAIT_BAR(4); }
    { const LAS unsigned char* kp_ = kp0;
      bf16x8 k8[8];
#pragma unroll
      for (int i = 0; i < 8; ++i) k8[i] = D2_KF(kp_, i);
      pA0 = D2_MFMA(k8[0], qr[0], (f32x16{})); pA1 = D2_MFMA(k8[1], qr[0], (f32x16{})); pA0 = D2_MFMA(k8[2], qr[1], pA0); pA1 = D2_MFMA(k8[3], qr[1], pA1);
      pA0 = D2_MFMA(k8[4], qr[2], pA0); pA1 = D2_MFMA(k8[5], qr[2], pA1); pA0 = D2_MFMA(k8[6], qr[3], pA0); pA1 = D2_MFMA(k8[7], qr[3], pA1);
      D2_ISSUE(0);
      if constexpr (!FAST) m = bf2f(f2bf(rowmax(pA0, pA1)));
#pragma unroll
      for (int r = 0; r < 16; ++r) { if constexpr (FAST) { pA0[r] = __builtin_amdgcn_exp2f(pA0[r]); pA1[r] = __builtin_amdgcn_exp2f(pA1[r]); } else { pA0[r] = __builtin_amdgcn_exp2f(pA0[r] - m); pA1[r] = __builtin_amdgcn_exp2f(pA1[r] - m); } }
    }
    if ((0) + 3 < NT) { D2_WAIT_BAR(4); } else { D2_WAIT_BAR(2); }
    D2_ROT();
    if (NT > 2 || full_last) {
#pragma unroll
        for (int i = 0; i < 4; ++i) kfr[i] = D2_KF(kp0 + SLK, i); }
    int t = 1;
    for (; t + 1 <= NT - 2; t += 2) {
        D2_STEP(pB0, pB1, pA0, pA1, t, true);                         D2_CLOSE(t);
        D2_STEP(pA0, pA1, pB0, pB1, t + 1, (full_last || t + 3 <= NT - 1)); D2_CLOSE(t + 1);
    }
    if (full_last) {
        D2_STEP(pB0, pB1, pA0, pA1, NT - 1, false); D2_CLOSE(NT - 1);
        D2_PVSTEP(pB0, pB1, NT); D2_WAIT_BAR(0);
    } else {
        D2_PVSTEP(pA0, pA1, NT - 1); D2_CLOSE(NT - 1);
        D2_WAIT_BAR(0);
    }
    unsigned ntk_ = 0u; if (tid == 448) ntk_ = __hip_atomic_fetch_add(qctr, 1u, __ATOMIC_RELAXED, __HIP_MEMORY_SCOPE_AGENT);
    l = hswap_sum(l);
    { const float inv = (sm ? lam : 1.f) / l;
      if (hi == 0) wsf[r32] = inv;
      asm volatile("s_waitcnt lgkmcnt(0)" ::: "memory");
#pragma unroll
      for (int g = 0; g < 4; ++g) { const f32x4 a4 = *(const LAS f32x4*)(wsf + 8 * g + 4 * hi);
#pragma unroll
          for (int blk = 0; blk < 4; ++blk)
#pragma unroll
              for (int i = 0; i < 4; ++i) o[blk][4 * g + i] *= a4[i]; } }
    constexpr int XP = 132;
    LAS float* X = (LAS float*)(lds + XOFF) + rb * (32 * XP);
    if (sm == 1) {
#pragma unroll
        for (int blk = 0; blk < 4; ++blk)
#pragma unroll
            for (int r = 0; r < 16; ++r) X[((r & 3) + 8 * (r >> 2) + 4 * hi) * XP + blk * 32 + r32] = o[blk][r];
    }
    D2_WAIT_BAR(0);
    if (sm == 0) {
#pragma unroll
        for (int blk = 0; blk < 4; ++blk)
#pragma unroll
            for (int r = 0; r < 16; ++r) { LAS float* xp = X + ((r & 3) + 8 * (r >> 2) + 4 * hi) * XP + blk * 32 + r32; *xp = o[blk][r] - *xp; }
    }
    asm volatile("s_waitcnt lgkmcnt(0)\n\ts_barrier" ::: "memory");
    { const int rg = lane >> 4, p = lane & 15;
      const f32x4 g0 = *(const f32x4*)(on_gain + 8 * p), g1 = *(const f32x4*)(on_gain + 8 * p + 4);
#pragma unroll
      for (int j = 0; j < 4; ++j) { const int row = 16 * sm + 4 * j + rg; const LAS float* xr = X + row * XP + 8 * p;
          const f32x4 v0 = *(const LAS f32x4*)xr, v1 = *(const LAS f32x4*)(xr + 4);
          float ss = ((v0[0] * v0[0] + v0[1] * v0[1]) + (v0[2] * v0[2] + v0[3] * v0[3])) + ((v1[0] * v1[0] + v1[1] * v1[1]) + (v1[2] * v1[2] + v1[3] * v1[3]));
          ss += __shfl_xor(ss, 1); ss += __shfl_xor(ss, 2); ss += __shfl_xor(ss, 4); ss += __shfl_xor(ss, 8);
          const float rstd = rsqrtf(ss * (1.f / 128.f) + EPS) * (127.f / MIX_RDA);
          const f32x4 e0 = v0 * rstd, e1 = v1 * rstd; v2u w8_; w8_.x = pack_i8x4(e0[0], e0[1], e0[2], e0[3]); w8_.y = pack_i8x4(e1[0], e1[1], e1[2], e1[3]);
          *(v2u*)((unsigned char*)MIX + (rowbase + q0 + row) * 1024 + h * 128 + 8 * p) = w8_; } }
    if (tid == 448) *qslot = ntk_;
    asm volatile("s_waitcnt lgkmcnt(0)\n\ts_barrier" ::: "memory");
}
}

namespace gla0 {
__device__ __forceinline__ void unit(LAS unsigned char* lds, int b, int h, const bf16* __restrict__ GQ, const bf16* __restrict__ GK, const bf16* __restrict__ GV, const bf16* __restrict__ GG, const float* __restrict__ GR,
                                     const float* __restrict__ gw, const float* __restrict__ gb, const float* __restrict__ on, bf16* MIX) {
    LAS float* q = (LAS float*)lds;
    LAS float* k = q + 4096; LAS float* EP = k + 4096; LAS float* v = EP + 4096;
    LAS float* Sst = v + 8192; LAS float* a = Sst + 8192; LAS float* Lmid = (LAS float*)(lds + XCH_OFF + 2048); LAS float* Lend = Lmid + 64;
    const int t = my_tid(); const size_t rowbase = (size_t)b * SEQ;
    for (int i = t; i < 8192; i += 512) Sst[i] = 0.f;
    for (int c = 0; c < 64; ++c) {
        __syncthreads();
        for (int i = t; i < 4096; i += 512) { const int r = i >> 6, d = i & 63; const size_t row = rowbase + c * 64 + r;
            q[i] = bf2f(GQ[row * 256 + h * 64 + d]); k[i] = bf2f(GK[row * 256 + h * 64 + d]);
            float z = gb[h * 64 + d];
#pragma unroll
            for (int rr = 0; rr < 16; ++rr) z += GR[row * 16 + rr] * gw[rr * 256 + h * 64 + d];
            const float ls = fminf(z, 0.f) - log1pf(expf(-fabsf(z)));
            EP[i] = ls * (1.f / 16.f); }
        for (int i = t; i < 8192; i += 512) { const int r = i >> 7, d = i & 127; v[i] = bf2f(GV[(rowbase + c * 64 + r) * 512 + h * 128 + d]); }
        __syncthreads();
        if (t < 64) { float s = 0.f; for (int r = 0; r < 64; ++r) { s += EP[r * 64 + t]; EP[r * 64 + t] = s; if (r == 31) Lmid[t] = s; } Lend[t] = s; }
        __syncthreads();
        for (int i = t; i < 4096; i += 512) { const int d = i & 63; const float lc = EP[i] - Lmid[d]; EP[i] = expf(lc); }
        __syncthreads();
        for (int i = t; i < 4096; i += 512) { const int ii = i >> 6, jj = i & 63; float s = 0.f;
            if (jj <= ii) { for (int d = 0; d < 64; ++d) s += q[ii * 64 + d] * EP[ii * 64 + d] * k[jj * 64 + d] / EP[jj * 64 + d]; }
            else          { for (int d = 0; d < 64; ++d) s += q[ii * 64 + d] / EP[ii * 64 + d] * k[jj * 64 + d] * EP[jj * 64 + d]; }
            a[i] = s; }
        __syncthreads();
        { const int ii = t >> 3, v0 = (t & 7) * 16; float o[16];
#pragma unroll
          for (int x = 0; x < 16; ++x) o[x] = 0.f;
          for (int j = 0; j < 64; ++j) { const float aij = a[ii * 64 + j];
#pragma unroll
              for (int x = 0; x < 16; ++x) o[x] += aij * v[j * 128 + v0 + x]; }
          for (int d = 0; d < 64; ++d) { const float qd = q[ii * 64 + d] * EP[ii * 64 + d] * expf(Lmid[d]);
#pragma unroll
              for (int x = 0; x < 16; ++x) o[x] += qd * Sst[d * 128 + v0 + x]; }
          float ss = 0.f;
#pragma unroll
          for (int x = 0; x < 16; ++x) ss += o[x] * o[x];
          ss += __shfl_xor(ss, 1); ss += __shfl_xor(ss, 2); ss += __shfl_xor(ss, 4);
          const float rs = rsqrtf(ss * (1.f / 128.f) + EPS);
          const size_t row = rowbase + c * 64 + ii;
          unsigned pk[8];
#pragma unroll
          for (int x = 0; x < 8; ++x) { const float g0 = bf2f(GG[row * 512 + h * 128 + v0 + 2 * x]), g1 = bf2f(GG[row * 512 + h * 128 + v0 + 2 * x + 1]);
              pk[x] = pk2(o[2 * x] * rs * on[v0 + 2 * x] * g0, o[2 * x + 1] * rs * on[v0 + 2 * x + 1] * g1); }
          v4u w0 = {pk[0], pk[1], pk[2], pk[3]}, w1 = {pk[4], pk[5], pk[6], pk[7]};
          *(v4u*)(MIX + row * 1024 + 512 + h * 128 + v0) = w0; *(v4u*)(MIX + row * 1024 + 512 + h * 128 + v0 + 8) = w1; }
        __syncthreads();
        { const int d = t >> 3, v0 = (t & 7) * 16; float u[16];
#pragma unroll
          for (int x = 0; x < 16; ++x) u[x] = 0.f;
          const float f = expf(Lend[d] - Lmid[d]);
          for (int j = 0; j < 64; ++j) { const float kd = k[j * 64 + d] / EP[j * 64 + d] * f;
#pragma unroll
              for (int x = 0; x < 16; ++x) u[x] += kd * v[j * 128 + v0 + x]; }
          const float dec = expf(Lend[d]);
#pragma unroll
          for (int x = 0; x < 16; ++x) Sst[d * 128 + v0 + x] = Sst[d * 128 + v0 + x] * dec + u[x]; }
    }
    __syncthreads();
}
}

namespace gla {
constexpr int T_QP = 0, T_QN = 8192, T_KP = 16384, T_KN = 24576, T_QL = 32768, T_KE = 40960, T_V = 49152  , T_S = 81920  , T_X = 114688  ;
constexpr int A_GW = 2048, A_DEC = 6144;
using da::s16x4; using da::vtr;
__device__ __forceinline__ float ex(float x) { return __builtin_amdgcn_exp2f(x * LOG2E); }
__device__ __forceinline__ float rdl(float v, int l) { return __builtin_bit_cast(float, __builtin_amdgcn_readlane(__builtin_bit_cast(int, v), l)); }
__device__ __forceinline__ void unit(LAS unsigned char* lds, LAS unsigned char* aux, int b, int h, const bf16* __restrict__ GQ, const bf16* __restrict__ GK, const bf16* __restrict__ GV, const bf16* __restrict__ GG, const float* __restrict__ GR,
                                     const float* __restrict__ gw, const float* __restrict__ gb, const float* __restrict__ on, bf16* MIX) {
    int tid_ = my_tid(); asm volatile("" : "+v"(tid_));
    const int tid = tid_, lane = tid & 63, r32 = lane & 31, hi = lane >> 5; const int wid = __builtin_amdgcn_readfirstlane(tid >> 6);
    const int ti = tid >> 3, vs = tid & 7, ib = wid >> 2, vb = wid & 3, dg = wid;
    const size_t rowbase = (size_t)b * SEQ;
    LAS float* GWL = (LAS float*)(aux + A_GW); LAS float* DEC = (LAS float*)(aux + A_DEC);
    LAS unsigned short* X = (LAS unsigned short*)(lds + T_X);
    for (int i = tid; i < 1024; i += 512) GWL[i] = gw[(i >> 6) * 256 + h * 64 + (i & 63)];
    float gbv[8], onv[16];
#pragma unroll
    for (int e = 0; e < 8; ++e) gbv[e] = gb[h * 64 + dg * 8 + e];
#pragma unroll
    for (int e = 0; e < 16; ++e) onv[e] = on[vs * 16 + e];
    { LAS v4u* z = (LAS v4u*)(lds + T_S); z[tid] = (v4u){0u, 0u, 0u, 0u}; z[tid + 512] = (v4u){0u, 0u, 0u, 0u}; }
    f32x16 S = f32x16{};
    const bf16* vsrc = GV + (rowbase + 16 * (wid & 3) + (lane >> 2)) * 512 + h * 128 + (wid >> 2) * 32 + (lane & 3) * 8;
#define GLA_VDMA(c_) do { const size_t go_ = (size_t)(c_) * 64 * 512; LAS unsigned char* vb_ = lds + T_V + ((c_) & 1) * 16384; \
        __builtin_amdgcn_global_load_lds((const unsigned*)(vsrc + go_), (LAS unsigned*)(vb_ + wid * 1024), 16, 0, 0); \
        __builtin_amdgcn_global_load_lds((const unsigned*)(vsrc + go_ + 64), (LAS unsigned*)(vb_ + (wid + 8) * 1024), 16, 0, 0); } while (0)
    size_t row = rowbase + lane;
    v4u qraw = *(const v4u*)(GQ + row * 256 + h * 64 + dg * 8), kraw = *(const v4u*)(GK + row * 256 + h * 64 + dg * 8);
    f32x4 grv[4];
#pragma unroll
    for (int i = 0; i < 4; ++i) grv[i] = *(const f32x4*)(GR + row * 16 + 4 * i);
    v4u gg0 = (v4u){0u, 0u, 0u, 0u}, gg1 = gg0;
    GLA_VDMA(0);
    __syncthreads();
    const int vpP = ((lane >> 4) & 1) * 32 + (lane & 3) * 8 + (4 * hi + ((lane & 15) >> 2)) * 64;
    const int vpN = ((lane >> 4) & 1) * 32 + (lane & 3) * 8 + (8 * hi + ((lane & 15) >> 2)) * 64;
#pragma unroll 1
    for (int c = 0; c <= 64; ++c) {
        if (c < 64) {
            float la[8];
#pragma unroll
            for (int e = 0; e < 8; ++e) la[e] = gbv[e];
#pragma unroll
            for (int r = 0; r < 16; ++r) { const f32x4 w0 = *(const LAS f32x4*)(GWL + r * 64 + dg * 8), w1 = *(const LAS f32x4*)(GWL + r * 64 + dg * 8 + 4); const float g = grv[r >> 2][r & 3];
#pragma unroll
                for (int e = 0; e < 4; ++e) { la[e] += g * w0[e]; la[4 + e] += g * w1[e]; } }
            const size_t rown = rowbase + (size_t)(c + 1) * 64 + lane;
            if (c < 63) {
#pragma unroll
                for (int i = 0; i < 4; ++i) grv[i] = *(const f32x4*)(GR + rown * 16 + 4 * i); }
#pragma unroll
            for (int e = 0; e < 8; ++e) { const float z = la[e]; la[e] = (fminf(z, 0.f) - __logf(1.f + ex(-fabsf(z)))) * (1.f / 16.f); }
            float midv[8], endv[8];
#pragma unroll
            for (int e = 0; e < 8; ++e) { float v = la[e];
                v += __builtin_bit_cast(float, __builtin_amdgcn_update_dpp(0, __builtin_bit_cast(int, v), 0x111, 0xf, 0xf, true));
                v += __builtin_bit_cast(float, __builtin_amdgcn_update_dpp(0, __builtin_bit_cast(int, v), 0x112, 0xf, 0xf, true));
                v += __builtin_bit_cast(float, __builtin_amdgcn_update_dpp(0, __builtin_bit_cast(int, v), 0x114, 0xf, 0xf, true));
                v += __builtin_bit_cast(float, __builtin_amdgcn_update_dpp(0, __builtin_bit_cast(int, v), 0x118, 0xf, 0xf, true));
                const float t0 = rdl(v, 15), t1 = rdl(v, 31), t2 = rdl(v, 47), t3 = rdl(v, 63);
                const float add = (lane < 16) ? 0.f : (lane < 32) ? t0 : (lane < 48) ? (t0 + t1) : (t0 + t1 + t2);
                la[e] = v + add; midv[e] = t0 + t1; endv[e] = (t0 + t1) + (t2 + t3); }
            float qf[8], kf[8];
#pragma unroll
            for (int e = 0; e < 4; ++e) { qf[2 * e] = __builtin_bit_cast(float, qraw[e] << 16); qf[2 * e + 1] = __builtin_bit_cast(float, qraw[e] & 0xffff0000u); kf[2 * e] = __builtin_bit_cast(float, kraw[e] << 16); kf[2 * e + 1] = __builtin_bit_cast(float, kraw[e] & 0xffff0000u); }
            if (c < 63) { qraw = *(const v4u*)(GQ + rown * 256 + h * 64 + dg * 8); kraw = *(const v4u*)(GK + rown * 256 + h * 64 + dg * 8); }
            float qp[8], qn[8], kp[8], kn[8], ql[8], ke[8];
#pragma unroll
            for (int e = 0; e < 8; ++e) { const float mid = midv[e], end = endv[e];
                const float lc = la[e] - mid, ep = ex(lc), en = ex(-lc), fm = ex(mid), fe = ex(end - mid);
                qp[e] = qf[e] * ep; qn[e] = qf[e] * en; kp[e] = kf[e] * ep; kn[e] = kf[e] * en; ql[e] = qp[e] * fm; ke[e] = kn[e] * fe;
                if (lane == 0) DEC[dg * 8 + e] = ex(end); }
            const int to = dg * 1024 + lane * 16;
            *(LAS v4u*)(lds + T_QP + to) = (v4u){cvt_pk_bf16(qp[0], qp[1]), cvt_pk_bf16(qp[2], qp[3]), cvt_pk_bf16(qp[4], qp[5]), cvt_pk_bf16(qp[6], qp[7])};
            *(LAS v4u*)(lds + T_QN + to) = (v4u){cvt_pk_bf16(qn[0], qn[1]), cvt_pk_bf16(qn[2], qn[3]), cvt_pk_bf16(qn[4], qn[5]), cvt_pk_bf16(qn[6], qn[7])};
            *(LAS v4u*)(lds + T_KP + to) = (v4u){cvt_pk_bf16(kp[0], kp[1]), cvt_pk_bf16(kp[2], kp[3]), cvt_pk_bf16(kp[4], kp[5]), cvt_pk_bf16(kp[6], kp[7])};
            *(LAS v4u*)(lds + T_KN + to) = (v4u){cvt_pk_bf16(kn[0], kn[1]), cvt_pk_bf16(kn[2], kn[3]), cvt_pk_bf16(kn[4], kn[5]), cvt_pk_bf16(kn[6], kn[7])};
            *(LAS v4u*)(lds + T_QL + to) = (v4u){cvt_pk_bf16(ql[0], ql[1]), cvt_pk_bf16(ql[2], ql[3]), cvt_pk_bf16(ql[4], ql[5]), cvt_pk_bf16(ql[6], ql[7])};
            *(LAS v4u*)(lds + T_KE + to) = (v4u){cvt_pk_bf16(ke[0], ke[1]), cvt_pk_bf16(ke[2], ke[3]), cvt_pk_bf16(ke[4], ke[5]), cvt_pk_bf16(ke[6], ke[7])};
        }
        if (c > 0) {
            const LAS v4u* xr = (const LAS v4u*)(X + ti * 128 + vs * 16);
            f32x4 o4[4]; float ss = 0.f;
#pragma unroll
            for (int i = 0; i < 2; ++i) { const v4u xw = xr[i];
#pragma unroll
                for (int e = 0; e < 2; ++e) { o4[2 * i + e] = (f32x4){__builtin_bit_cast(float, xw[2 * e] << 16), __builtin_bit_cast(float, xw[2 * e] & 0xffff0000u), __builtin_bit_cast(float, xw[2 * e + 1] << 16), __builtin_bit_cast(float, xw[2 * e + 1] & 0xffff0000u)}; } }
#pragma unroll
            for (int i = 0; i < 4; ++i) ss += (o4[i][0] * o4[i][0] + o4[i][1] * o4[i][1]) + (o4[i][2] * o4[i][2] + o4[i][3] * o4[i][3]);
            ss += __shfl_xor(ss, 1); ss += __shfl_xor(ss, 2); ss += __shfl_xor(ss, 4);
            const float rs = rsqrtf(ss * (1.f / 128.f) + EPS);
            float gf[16];
#pragma unroll
            for (int e = 0; e < 4; ++e) { gf[2 * e] = __builtin_bit_cast(float, gg0[e] << 16); gf[2 * e + 1] = __builtin_bit_cast(float, gg0[e] & 0xffff0000u); gf[8 + 2 * e] = __builtin_bit_cast(float, gg1[e] << 16); gf[9 + 2 * e] = __builtin_bit_cast(float, gg1[e] & 0xffff0000u); }
            v4u w0, w1;
#pragma unroll
            for (int e = 0; e < 4; ++e) { w0[e] = cvt_pk_bf16(o4[e >> 1][(2 * e) & 3] * rs * onv[2 * e] * gf[2 * e], o4[e >> 1][(2 * e + 1) & 3] * rs * onv[2 * e + 1] * gf[2 * e + 1]);
                w1[e] = cvt_pk_bf16(o4[2 + (e >> 1)][(2 * e) & 3] * rs * onv[8 + 2 * e] * gf[8 + 2 * e], o4[2 + (e >> 1)][(2 * e + 1) & 3] * rs * onv[9 + 2 * e] * gf[9 + 2 * e]); }
            bf16* op = MIX + (rowbase + (size_t)(c - 1) * 64 + ti) * 1024 + 512 + h * 128 + vs * 16;
            *(v4u*)op = w0; *(v4u*)(op + 8) = w1;
        }
        if (c == 64) break;
        if (c == 0) asm volatile("s_waitcnt vmcnt(6) lgkmcnt(0)\n\ts_barrier" ::: "memory");
        else if (c == 63) asm volatile("s_waitcnt vmcnt(2) lgkmcnt(0)\n\ts_barrier" ::: "memory");
        else asm volatile("s_waitcnt vmcnt(8) lgkmcnt(0)\n\ts_barrier" ::: "memory");
        { const size_t rg = rowbase + (size_t)c * 64 + ti; gg0 = *(const v4u*)(GG + rg * 512 + h * 128 + vs * 16); gg1 = *(const v4u*)(GG + rg * 512 + h * 128 + vs * 16 + 8); }
        if (c < 63) GLA_VDMA(c + 1);
        f32x16 O = f32x16{};
        {
            const LAS unsigned char* fq_ = lds + hi * 1024 + (32 * ib + r32) * 16;
            v4u pw[2][2];
#pragma unroll
            for (int jb = 0; jb < 2; ++jb) {
                const LAS unsigned char* fk_ = lds + hi * 1024 + (32 * jb + r32) * 16;
                f32x16 past = f32x16{}, fut = f32x16{};
                if (jb <= ib) {
#pragma unroll
                    for (int d0 = 0; d0 < 4; ++d0) past = __builtin_amdgcn_mfma_f32_32x32x16_bf16(*(const LAS bf16x8*)(fk_ + T_KN + d0 * 2048), *(const LAS bf16x8*)(fq_ + T_QP + d0 * 2048), past, 0, 0, 0); }
                if (jb >= ib) {
#pragma unroll
                    for (int d0 = 0; d0 < 4; ++d0) fut = __builtin_amdgcn_mfma_f32_32x32x16_bf16(*(const LAS bf16x8*)(fk_ + T_KP + d0 * 2048), *(const LAS bf16x8*)(fq_ + T_QN + d0 * 2048), fut, 0, 0, 0); }
                f32x16 a;
                if (jb < ib) a = past; else if (jb > ib) a = fut; else {
#pragma unroll
                    for (int r = 0; r < 16; ++r) a[r] = (((r & 3) + 8 * (r >> 2) + 4 * hi) <= r32) ? past[r] : fut[r]; }
#pragma unroll
                for (int i = 0; i < 4; ++i) { pw[jb][0][i] = cvtpk_s(a[2 * i], a[2 * i + 1]); pw[jb][1][i] = cvtpk_s(a[8 + 2 * i], a[9 + 2 * i]); }
            }
#pragma unroll
            for (int jb = 0; jb < 2; ++jb)
#pragma unroll
                for (int s = 0; s < 2; ++s) { const LAS unsigned char* vp = lds + T_V + (c & 1) * 16384 + (vb * 4 + 2 * jb + s) * 1024 + vpP;
                    const s16x4 lo = vtr(vp), hh = vtr(vp + 512);
                    O = __builtin_amdgcn_mfma_f32_32x32x16_bf16(__builtin_bit_cast(bf16x8, pw[jb][s]), (bf16x8){lo[0], lo[1], lo[2], lo[3], hh[0], hh[1], hh[2], hh[3]}, O, 0, 0, 0); }
            const LAS unsigned char* sp = lds + T_S + (c & 1) * 16384 + hi * 2048 + (32 * vb + r32) * 16;
#pragma unroll
            for (int s = 0; s < 4; ++s)
                O = __builtin_amdgcn_mfma_f32_32x32x16_bf16(*(const LAS bf16x8*)(fq_ + T_QL + s * 2048), *(const LAS bf16x8*)(sp + s * 4096), O, 0, 0, 0);
            f32x16 U = f32x16{};
            const int kd0 = 32 * ib + 16 * ((lane >> 4) & 1) + 4 * (lane & 3);
            const LAS unsigned char* kep = lds + T_KE + (kd0 >> 3) * 1024 + (8 * hi + ((lane & 15) >> 2)) * 16 + (kd0 & 7) * 2;
            const LAS unsigned char* vn = lds + T_V + (c & 1) * 16384 + vb * 4096 + vpN;
#pragma unroll
            for (int s = 0; s < 4; ++s) { const s16x4 lo = vtr(vn + s * 1024), hh = vtr(vn + s * 1024 + 256);
                const s16x4 kl = vtr(kep + s * 256), kh = vtr(kep + s * 256 + 64);
                U = __builtin_amdgcn_mfma_f32_32x32x16_bf16((bf16x8){kl[0], kl[1], kl[2], kl[3], kh[0], kh[1], kh[2], kh[3]}, (bf16x8){lo[0], lo[1], lo[2], lo[3], hh[0], hh[1], hh[2], hh[3]}, U, 0, 0, 0); }
            LAS unsigned char* sw = lds + T_S + ((c + 1) & 1) * 16384 + (32 * vb + r32) * 16 + 8 * hi;
#pragma unroll
            for (int g = 0; g < 4; ++g) { const f32x4 d4 = *(const LAS f32x4*)(DEC + 32 * ib + 8 * g + 4 * hi);
#pragma unroll
                for (int i = 0; i < 4; ++i) { const int r = 4 * g + i; S[r] = S[r] * d4[i] + U[r];
                    X[(32 * ib + 8 * g + 4 * hi + i) * 128 + 32 * vb + r32] = (unsigned short)f2bf(O[r]); }
                *(LAS v2u*)(sw + (4 * ib + g) * 2048) = (v2u){cvtpk_s(S[4 * g], S[4 * g + 1]), cvtpk_s(S[4 * g + 2], S[4 * g + 3])}; }
        }
        asm volatile("s_waitcnt lgkmcnt(0)\n\ts_barrier" ::: "memory");
    }
    asm volatile("s_waitcnt vmcnt(0) lgkmcnt(0)\n\ts_barrier" ::: "memory");
#undef GLA_VDMA
}
}

namespace gla2 {
constexpr int T_QP = 0, T_QN = 8192, T_KP = 16384, T_KN = 24576, T_KE = 32768, T_V = 40960;
constexpr int S_QL = 0  , S_ST = 24576  , S_X = 57344  , S_DEC = 90112  ;
using da::s16x4; using da::vtr; using gla::ex; using gla::rdl;

__device__ __forceinline__ void prep_units(LAS unsigned char* lds, LAS unsigned char* aux, int u0, int ustep, int uend, const bf16* __restrict__ GQ, const bf16* __restrict__ GK, const bf16* __restrict__ GV, const float* __restrict__ GR,
                                           const float* __restrict__ gw, const float* __restrict__ gb, unsigned char* QLG, unsigned char* OIG, unsigned char* UG, float* DECG) {
    int tid_ = my_tid(); asm volatile("" : "+v"(tid_));
    const int tid = tid_, lane = tid & 63, r32 = lane & 31, hi = lane >> 5; const int wid = __builtin_amdgcn_readfirstlane(tid >> 6);
    const int ib = wid >> 2, vb = wid & 3, dg = wid;
    if (u0 >= uend) return;
    const int h = (u0 >> 6) & 3;
    LAS float* GWL = (LAS float*)(aux + 2048);
    for (int i = tid; i < 1024; i += 512) GWL[i] = gw[(i >> 6) * 256 + h * 64 + (i & 63)];
    float gbv[8];
#pragma unroll
    for (int e = 0; e < 8; ++e) gbv[e] = gb[h * 64 + dg * 8 + e];
    v4u qraw, kraw; f32x4 grv[4];
    { const int c0 = u0 & 63, b0 = u0 >> 8; const size_t row0 = (size_t)b0 * SEQ + (size_t)c0 * 64 + lane;
      const bf16* vsrc = GV + ((size_t)b0 * SEQ + (size_t)c0 * 64 + 16 * (wid & 3) + (lane >> 2)) * 512 + h * 128 + (wid >> 2) * 32 + (lane & 3) * 8;
      __builtin_amdgcn_global_load_lds((const unsigned*)vsrc, (LAS unsigned*)(lds + T_V + wid * 1024), 16, 0, 0);
      __builtin_amdgcn_global_load_lds((const unsigned*)(vsrc + 64), (LAS unsigned*)(lds + T_V + (wid + 8) * 1024), 16, 0, 0);
      qraw = *(const v4u*)(GQ + row0 * 256 + h * 64 + dg * 8); kraw = *(const v4u*)(GK + row0 * 256 + h * 64 + dg * 8);
#pragma unroll
      for (int i = 0; i < 4; ++i) grv[i] = *(const f32x4*)(GR + row0 * 16 + 4 * i); }
    __syncthreads();
    int vsel = 0;
#pragma unroll 1
    for (int u = u0; u < uend; u += ustep) {
    float la[8];
#pragma unroll
    for (int e = 0; e < 8; ++e) la[e] = gbv[e];
#pragma unroll
    for (int r = 0; r < 16; ++r) { const f32x4 w0 = *(const LAS f32x4*)(GWL + r * 64 + dg * 8), w1 = *(const LAS f32x4*)(GWL + r * 64 + dg * 8 + 4); const float g = grv[r >> 2][r & 3];
#pragma unroll
        for (int e = 0; e < 4; ++e) { la[e] += g * w0[e]; la[4 + e] += g * w1[e]; } }
#pragma unroll
    for (int e = 0; e < 8; ++e) { const float z = la[e]; la[e] = (fminf(z, 0.f) - __logf(1.f + ex(-fabsf(z)))) * (1.f / 16.f); }
    float midv[8], endv[8]; v4u qlpk;
#pragma unroll
    for (int e = 0; e < 8; ++e) { float v = la[e];
        v += __builtin_bit_cast(float, __builtin_amdgcn_update_dpp(0, __builtin_bit_cast(int, v), 0x111, 0xf, 0xf, true));
        v += __builtin_bit_cast(float, __builtin_amdgcn_update_dpp(0, __builtin_bit_cast(int, v), 0x112, 0xf, 0xf, true));
        v += __builtin_bit_cast(float, __builtin_amdgcn_update_dpp(0, __builtin_bit_cast(int, v), 0x114, 0xf, 0xf, true));
        v += __builtin_bit_cast(float, __builtin_amdgcn_update_dpp(0, __builtin_bit_cast(int, v), 0x118, 0xf, 0xf, true));
        const float t0 = rdl(v, 15), t1 = rdl(v, 31), t2 = rdl(v, 47), t3 = rdl(v, 63);
        const float add = (lane < 16) ? 0.f : (lane < 32) ? t0 : (lane < 48) ? (t0 + t1) : (t0 + t1 + t2);
        la[e] = v + add; midv[e] = t0 + t1; endv[e] = (t0 + t1) + (t2 + t3); }
    { float qf[8], kf[8];
#pragma unroll
      for (int e = 0; e < 4; ++e) { qf[2 * e] = __builtin_bit_cast(float, qraw[e] << 16); qf[2 * e + 1] = __builtin_bit_cast(float, qraw[e] & 0xffff0000u); kf[2 * e] = __builtin_bit_cast(float, kraw[e] << 16); kf[2 * e + 1] = __builtin_bit_cast(float, kraw[e] & 0xffff0000u); }
      float qp[8], qn[8], kp[8], kn[8], ql[8], ke[8];
#pragma unroll
      for (int e = 0; e < 8; ++e) { const float mid = midv[e], end = endv[e];
          const float lc = la[e] - mid, ep = ex(lc), en = ex(-lc), fm = ex(mid), fe = ex(end - mid);
          qp[e] = qf[e] * ep; qn[e] = qf[e] * en; kp[e] = kf[e] * ep; kn[e] = kf[e] * en; ql[e] = qp[e] * fm; ke[e] = kn[e] * fe; }
      const int to = dg * 1024 + lane * 16;
      *(LAS v4u*)(lds + T_QP + to) = (v4u){cvt_pk_bf16(qp[0], qp[1]), cvt_pk_bf16(qp[2], qp[3]), cvt_pk_bf16(qp[4], qp[5]), cvt_pk_bf16(qp[6], qp[7])};
      *(LAS v4u*)(lds + T_QN + to) = (v4u){cvt_pk_bf16(qn[0], qn[1]), cvt_pk_bf16(qn[2], qn[3]), cvt_pk_bf16(qn[4], qn[5]), cvt_pk_bf16(qn[6], qn[7])};
      *(LAS v4u*)(lds + T_KP + to) = (v4u){cvt_pk_bf16(kp[0], kp[1]), cvt_pk_bf16(kp[2], kp[3]), cvt_pk_bf16(kp[4], kp[5]), cvt_pk_bf16(kp[6], kp[7])};
      *(LAS v4u*)(lds + T_KN + to) = (v4u){cvt_pk_bf16(kn[0], kn[1]), cvt_pk_bf16(kn[2], kn[3]), cvt_pk_bf16(kn[4], kn[5]), cvt_pk_bf16(kn[6], kn[7])};
      *(LAS v4u*)(lds + T_KE + to) = (v4u){cvt_pk_bf16(ke[0], ke[1]), cvt_pk_bf16(ke[2], ke[3]), cvt_pk_bf16(ke[4], ke[5]), cvt_pk_bf16(ke[6], ke[7])};
      qlpk = (v4u){cvt_pk_bf16(ql[0], ql[1]), cvt_pk_bf16(ql[2], ql[3]), cvt_pk_bf16(ql[4], ql[5]), cvt_pk_bf16(ql[6], ql[7])}; }
    if (u + ustep < uend) { const int un = u + ustep; const int cn = un & 63, bn = un >> 8; const size_t rown = (size_t)bn * SEQ + (size_t)cn * 64 + lane;
        qraw = *(const v4u*)(GQ + rown * 256 + h * 64 + dg * 8); kraw = *(const v4u*)(GK + rown * 256 + h * 64 + dg * 8);
#pragma unroll
        for (int i = 0; i < 4; ++i) grv[i] = *(const f32x4*)(GR + rown * 16 + 4 * i);
        const bf16* vsrc = GV + ((size_t)bn * SEQ + (size_t)cn * 64 + 16 * (wid & 3) + (lane >> 2)) * 512 + h * 128 + (wid >> 2) * 32 + (lane & 3) * 8;
        LAS unsigned char* vbn = lds + T_V + (vsel ^ 1) * 16384;
        __builtin_amdgcn_global_load_lds((const unsigned*)vsrc, (LAS unsigned*)(vbn + wid * 1024), 16, 0, 0);
        __builtin_amdgcn_global_load_lds((const unsigned*)(vsrc + 64), (LAS unsigned*)(vbn + (wid + 8) * 1024), 16, 0, 0);
        asm volatile("s_waitcnt vmcnt(12) lgkmcnt(0)\n\ts_barrier" ::: "memory"); }
    else asm volatile("s_waitcnt vmcnt(0) lgkmcnt(0)\n\ts_barrier" ::: "memory");
    *(v4u*)(QLG + (size_t)u * 8192 + dg * 1024 + lane * 16) = qlpk;
    if (lane == 0) { f32x4 d0_, d1_;
#pragma unroll
        for (int e = 0; e < 4; ++e) { d0_[e] = ex(endv[e]); d1_[e] = ex(endv[4 + e]); }
        *(f32x4*)(DECG + (size_t)u * 64 + dg * 8) = d0_; *(f32x4*)(DECG + (size_t)u * 64 + dg * 8 + 4) = d1_; }
    const int vpP = ((lane >> 4) & 1) * 32 + (lane & 3) * 8 + (4 * hi + ((lane & 15) >> 2)) * 64;
    const int vpN = ((lane >> 4) & 1) * 32 + (lane & 3) * 8 + (8 * hi + ((lane & 15) >> 2)) * 64;
    f32x16 O = f32x16{}, U = f32x16{};
    { const LAS unsigned char* fq_ = lds + hi * 1024 + (32 * ib + r32) * 16;
      v4u pw[2][2];
#pragma unroll
      for (int jb = 0; jb < 2; ++jb) {
          const LAS unsigned char* fk_ = lds + hi * 1024 + (32 * jb + r32) * 16;
          f32x16 past = f32x16{}, fut = f32x16{};
          if (jb <= ib) {
#pragma unroll
              for (int d0 = 0; d0 < 4; ++d0) past = __builtin_amdgcn_mfma_f32_32x32x16_bf16(*(const LAS bf16x8*)(fk_ + T_KN + d0 * 2048), *(const LAS bf16x8*)(fq_ + T_QP + d0 * 2048), past, 0, 0, 0); }
          if (jb >= ib) {
#pragma unroll
              for (int d0 = 0; d0 < 4; ++d0) fut = __builtin_amdgcn_mfma_f32_32x32x16_bf16(*(const LAS bf16x8*)(fk_ + T_KP + d0 * 2048), *(const LAS bf16x8*)(fq_ + T_QN + d0 * 2048), fut, 0, 0, 0); }
          f32x16 a;
          if (jb < ib) a = past; else if (jb > ib) a = fut; else {
#pragma unroll
              for (int r = 0; r < 16; ++r) a[r] = (((r & 3) + 8 * (r >> 2) + 4 * hi) <= r32) ? past[r] : fut[r]; }
#pragma unroll
          for (int i = 0; i < 4; ++i) { pw[jb][0][i] = cvtpk_s(a[2 * i], a[2 * i + 1]); pw[jb][1][i] = cvtpk_s(a[8 + 2 * i], a[9 + 2 * i]); }
      }
#pragma unroll
      for (int jb = 0; jb < 2; ++jb)
#pragma unroll
          for (int s = 0; s < 2; ++s) { const LAS unsigned char* vp = lds + T_V + vsel * 16384 + (vb * 4 + 2 * jb + s) * 1024 + vpP;
              const s16x4 lo = vtr(vp), hh = vtr(vp + 512);
              O = __builtin_amdgcn_mfma_f32_32x32x16_bf16(__builtin_bit_cast(bf16x8, pw[jb][s]), (bf16x8){lo[0], lo[1], lo[2], lo[3], hh[0], hh[1], hh[2], hh[3]}, O, 0, 0, 0); }
      const int kd0 = 32 * ib + 16 * ((lane >> 4) & 1) + 4 * (lane & 3);
      const LAS unsigned char* kep = lds + T_KE + (kd0 >> 3) * 1024 + (8 * hi + ((lane & 15) >> 2)) * 16 + (kd0 & 7) * 2;
      const LAS unsigned char* vn = lds + T_V + vsel * 16384 + vb * 4096 + vpN;
#pragma unroll
      for (int s = 0; s < 4; ++s) { const s16x4 lo = vtr(vn + s * 1024), hh = vtr(vn + s * 1024 + 256); const s16x4 kl = vtr(kep + s * 256), kh = vtr(kep + s * 256 + 64);
          U = __builtin_amdgcn_mfma_f32_32x32x16_bf16((bf16x8){kl[0], kl[1], kl[2], kl[3], kh[0], kh[1], kh[2], kh[3]}, (bf16x8){lo[0], lo[1], lo[2], lo[3], hh[0], hh[1], hh[2], hh[3]}, U, 0, 0, 0); } }
    { v4u* od = (v4u*)(OIG + (size_t)u * 16384 + wid * 2048 + lane * 32); v4u* ud = (v4u*)(UG + (size_t)u * 16384 + wid * 2048 + lane * 32);
      od[0] = (v4u){cvtpk_s(O[0], O[1]), cvtpk_s(O[2], O[3]), cvtpk_s(O[4], O[5]), cvtpk_s(O[6], O[7])}; od[1] = (v4u){cvtpk_s(O[8], O[9]), cvtpk_s(O[10], O[11]), cvtpk_s(O[12], O[13]), cvtpk_s(O[14], O[15])};
      ud[0] = (v4u){cvtpk_s(U[0], U[1]), cvtpk_s(U[2], U[3]), cvtpk_s(U[4], U[5]), cvtpk_s(U[6], U[7])}; ud[1] = (v4u){cvtpk_s(U[8], U[9]), cvtpk_s(U[10], U[11]), cvtpk_s(U[12], U[13]), cvtpk_s(U[14], U[15])}; }
    asm volatile("s_waitcnt lgkmcnt(0)\n\ts_barrier" ::: "memory");
    vsel ^= 1;
    }
}
__device__ __forceinline__ void seq_unit(LAS unsigned char* lds, int bh, const bf16* __restrict__ GG, const float* __restrict__ on, const unsigned char* QLG, const unsigned char* OIG, const unsigned char* UG, const float* DECG, bf16* MIX) {
    int tid_ = my_tid(); asm volatile("" : "+v"(tid_));
    const int tid = tid_, lane = tid & 63, r32 = lane & 31, hi = lane >> 5; const int wid = __builtin_amdgcn_readfirstlane(tid >> 6);
    const int ti = tid >> 3, vs = tid & 7, ib = wid >> 2, vb = wid & 3;
    const int b = bh >> 2, h = bh & 3; const size_t rowbase = (size_t)b * SEQ; const size_t u0 = (size_t)bh * 64;
    float onv[16];
#pragma unroll
    for (int e = 0; e < 16; ++e) onv[e] = on[vs * 16 + e];
    { LAS v4u* z = (LAS v4u*)(lds + S_ST); z[tid] = (v4u){0u, 0u, 0u, 0u}; z[tid + 512] = (v4u){0u, 0u, 0u, 0u}; }
    f32x16 S = f32x16{};
#define SQ_QLDMA(c_) __builtin_amdgcn_global_load_lds((const unsigned*)(QLG + (u0 + (c_)) * 8192 + wid * 1024 + lane * 16), (LAS unsigned*)(lds + S_QL + ((c_) % 3) * 8192 + wid * 1024), 16, 0, 0)
#define SQ_DECDMA(c_) __builtin_amdgcn_global_load_lds((const unsigned*)(DECG + (u0 + (c_)) * 64 + lane), (LAS unsigned*)(lds + S_DEC + ((c_) % 3) * 256), 4, 0, 0)
    SQ_QLDMA(0); SQ_DECDMA(0); SQ_QLDMA(1); SQ_DECDMA(1);
    v4u oiA0, oiA1, uuA0, uuA1, ggA0, ggA1, oiB0, oiB1, uuB0, uuB1, ggB0, ggB1, oiC0, oiC1, uuC0, uuC1, ggC0, ggC1;
#define SQ_LOAD(c_, X) do { const size_t uo_ = (u0 + (c_)) * 16384 + wid * 2048 + lane * 32; oi##X##0 = *(const v4u*)(OIG + uo_); oi##X##1 = *(const v4u*)(OIG + uo_ + 16); uu##X##0 = *(const v4u*)(UG + uo_); uu##X##1 = *(const v4u*)(UG + uo_ + 16); \
        { const size_t rg_ = rowbase + (size_t)(c_) * 64 + ti; gg##X##0 = *(const v4u*)(GG + rg_ * 512 + h * 128 + vs * 16); gg##X##1 = *(const v4u*)(GG + rg_ * 512 + h * 128 + vs * 16 + 8); } } while (0)
    SQ_LOAD(0, A); SQ_LOAD(1, B);
    v4u pg0 = (v4u){0u, 0u, 0u, 0u}, pg1 = pg0;
#define SQ_ITER(c_, X, Y) { const int c = (c_); \
        if (c >= 2 && c <= 62) asm volatile("s_waitcnt vmcnt(10) lgkmcnt(0)\n\ts_barrier" ::: "memory"); else asm volatile("s_waitcnt vmcnt(0) lgkmcnt(0)\n\ts_barrier" ::: "memory"); \
        if (c < 64) { \
            if (c < 62) { SQ_QLDMA(c + 2); SQ_DECDMA(c + 2); } \
            if (c < 62) SQ_LOAD(c + 2, Y); \
        } \
        if (c > 0) {     \
            const LAS v4u* xr = (const LAS v4u*)(lds + S_X + ((c - 1) & 1) * 16384 + (ti * 128 + vs * 16) * 2); \
            f32x4 o4[4]; float ss = 0.f; \
            _Pragma("unroll") for (int i = 0; i < 2; ++i) { const v4u xw = xr[i]; \
                _Pragma("unroll") for (int e = 0; e < 2; ++e) o4[2 * i + e] = (f32x4){__builtin_bit_cast(float, xw[2 * e] << 16), __builtin_bit_cast(float, xw[2 * e] & 0xffff0000u), __builtin_bit_cast(float, xw[2 * e + 1] << 16), __builtin_bit_cast(float, xw[2 * e + 1] & 0xffff0000u)}; } \
            _Pragma("unroll") for (int i = 0; i < 4; ++i) ss += (o4[i][0] * o4[i][0] + o4[i][1] * o4[i][1]) + (o4[i][2] * o4[i][2] + o4[i][3] * o4[i][3]); \
            ss += __shfl_xor(ss, 1); ss += __shfl_xor(ss, 2); ss += __shfl_xor(ss, 4); \
            const float rs = rsqrtf(ss * (1.f / 128.f) + EPS); \
            float gf[16]; \
            _Pragma("unroll") for (int e = 0; e < 4; ++e) { gf[2 * e] = __builtin_bit_cast(float, pg0[e] << 16); gf[2 * e + 1] = __builtin_bit_cast(float, pg0[e] & 0xffff0000u); gf[8 + 2 * e] = __builtin_bit_cast(float, pg1[e] << 16); gf[9 + 2 * e] = __builtin_bit_cast(float, pg1[e] & 0xffff0000u); } \
            float ev[16]; const float rq_ = rs * (127.f / MIX_RGL);        \
            _Pragma("unroll") for (int e = 0; e < 4; ++e) { ev[2 * e] = o4[e >> 1][(2 * e) & 3] * rq_ * gf[2 * e]; ev[2 * e + 1] = o4[e >> 1][(2 * e + 1) & 3] * rq_ * gf[2 * e + 1]; \
                ev[8 + 2 * e] = o4[2 + (e >> 1)][(2 * e) & 3] * rq_ * gf[8 + 2 * e]; ev[9 + 2 * e] = o4[2 + (e >> 1)][(2 * e + 1) & 3] * rq_ * gf[9 + 2 * e]; } \
            v2u w0, w1; w0.x = pack_i8x4(ev[0], ev[1], ev[2], ev[3]); w0.y = pack_i8x4(ev[4], ev[5], ev[6], ev[7]); w1.x = pack_i8x4(ev[8], ev[9], ev[10], ev[11]); w1.y = pack_i8x4(ev[12], ev[13], ev[14], ev[15]); \
            unsigned char* op = (unsigned char*)MIX + (rowbase + (size_t)(c - 1) * 64 + ti) * 1024 + 512 + h * 128 + vs * 16; \
            *(v2u*)op = w0; *(v2u*)(op + 8) = w1;        \
        } \
        if (c == 64) goto sq_done_; \
          \
        f32x16 O; \
        _Pragma("unroll") for (int i = 0; i < 4; ++i) { O[2 * i] = __builtin_bit_cast(float, oi##X##0[i] << 16); O[2 * i + 1] = __builtin_bit_cast(float, oi##X##0[i] & 0xffff0000u); O[8 + 2 * i] = __builtin_bit_cast(float, oi##X##1[i] << 16); O[9 + 2 * i] = __builtin_bit_cast(float, oi##X##1[i] & 0xffff0000u); } \
        { const LAS unsigned char* fq_ = lds + S_QL + (c % 3) * 8192 + hi * 1024 + (32 * ib + r32) * 16; \
          const LAS unsigned char* sp = lds + S_ST + (c & 1) * 16384 + hi * 2048 + (32 * vb + r32) * 16; \
          _Pragma("unroll") for (int s_ = 0; s_ < 4; ++s_) O = __builtin_amdgcn_mfma_f32_32x32x16_bf16(*(const LAS bf16x8*)(fq_ + s_ * 2048), *(const LAS bf16x8*)(sp + s_ * 4096), O, 0, 0, 0); } \
        { LAS unsigned char* sw = lds + S_ST + ((c + 1) & 1) * 16384 + (32 * vb + r32) * 16 + 8 * hi; \
          LAS unsigned short* X_ = (LAS unsigned short*)(lds + S_X + (c & 1) * 16384); \
          _Pragma("unroll") for (int g = 0; g < 4; ++g) { const f32x4 dd_ = *(const LAS f32x4*)(lds + S_DEC + (c % 3) * 256 + (32 * ib + 8 * g + 4 * hi) * 4); \
              _Pragma("unroll") for (int i = 0; i < 4; ++i) { const int r = 4 * g + i; const unsigned uw_ = (r < 8 ? uu##X##0 : uu##X##1)[(r & 7) >> 1]; \
                  S[r] = S[r] * dd_[i] + ((r & 1) ? __builtin_bit_cast(float, uw_ & 0xffff0000u) : __builtin_bit_cast(float, uw_ << 16)); \
                  X_[(32 * ib + 8 * g + 4 * hi + i) * 128 + 32 * vb + r32] = (unsigned short)f2bf(O[r]); } \
              *(LAS v2u*)(sw + (4 * ib + g) * 2048) = (v2u){cvtpk_s(S[4 * g], S[4 * g + 1]), cvtpk_s(S[4 * g + 2], S[4 * g + 3])}; } } \
        pg0 = gg##X##0; pg1 = gg##X##1; }
#pragma unroll 1
    for (int c3 = 0; ; c3 += 3) { SQ_ITER(c3, A, C) SQ_ITER(c3 + 1, B, A) SQ_ITER(c3 + 2, C, B) }
sq_done_:
    asm volatile("s_waitcnt vmcnt(0) lgkmcnt(0)\n\ts_barrier" ::: "memory");
#undef SQ_ITER
#undef SQ_DECDMA
#undef SQ_QLDMA
#undef SQ_LOAD
}
}

struct Args { const float* in[30]; float* out; unsigned char* ws; int ph_lo, ph_hi; };
__global__ void __launch_bounds__(NWAVES * 64, 2) mega(Args args) {
    extern __shared__ __attribute__((aligned(16))) unsigned char lds_[];
    Frame F;
    F.lds = (LAS unsigned char*)lds_;
    volatile LAS unsigned* MISC = (volatile LAS unsigned*)(F.lds + MISC_OFF);
    { const int t0 = (int)threadIdx.x; F.tid = t0; F.lane = t0 & 63; F.wave = __builtin_amdgcn_readfirstlane(t0 >> 6); }
    F.G = gridDim.x; { const int bx = blockIdx.x; F.vcu = (F.G % 8 == 0) ? (bx % 8) * (F.G / 8) + bx / 8 : bx; }
    unsigned char* ws = args.ws;
    gu32* ctl = (gu32*)(ws + WS_CTL);
    for (int u = F.tid; u < (LDS_BYTES - MISC_OFF) / 4; u += NWAVES * 64) ((LAS unsigned*)(F.lds + MISC_OFF))[u] = 0u;
    __syncthreads();
    if (F.lane == 0) *(volatile LAS int*)(unsigned long)(WTAB_LDS_OFF + 4u * ((unsigned)__builtin_amdgcn_s_getreg((5 << 11) | 4) & 63u)) = F.wave;
    asm volatile("s_waitcnt lgkmcnt(0)" ::: "memory");
    refresh(F);
    XcdBarrier bar = xcd_barrier_post((unsigned*)ctl + CW_BAR, MISC + 8);
    const int lo = args.ph_lo, hi = args.ph_hi;
#define IN(k) (lo <= (k) && (k) < hi)
#define BOTH(k) (IN(k) && IN((k) + 1))
    LAS float* xch = (LAS float*)(F.lds + XCH_OFF);
    LAS unsigned char* idxl = F.lds + IDX_OFF;
    if (IN(0)) { p0_prologue(F, args.in, ws); if (BOTH(0)) xcd_barrier(bar); }
    if (IN(1)) {
        EpiIn E{(bf16*)(ws + WS_RB), (bf16*)(ws + WS_RB) + (size_t)T * 512, (bf16*)(ws + WS_RB) + (size_t)T * 1024,
                (bf16*)(ws + WS_RC), (bf16*)(ws + WS_RC) + (size_t)T * 256, (bf16*)(ws + WS_RC) + (size_t)T * 512, (bf16*)(ws + WS_RC) + (size_t)T * 1024, args.in[4], args.in[5], (const float*)(ws + WS_SA), (const float*)(ws + WS_SB), xch};
        { OrderMN S; S.init(ws + WS_RA, 1024, ws + WS_WIN, 1024, T, 3072, F.G, (int)blockIdx.x);
          pg8::gemm_phase<EpiIn, OrderMN, false, true>(F.lds + RING_OFF, idxl, 1024, 1024, 512  , S, E, ws); }
        if (BOTH(1)) xcd_barrier(bar);
    }
    if (IN(2)) {
        const bf16* DQ = (const bf16*)(ws + WS_RB); const bf16* DK = DQ + (size_t)T * 512; const bf16* DV = DQ + (size_t)T * 1024;
        const bf16* GQ = (const bf16*)(ws + WS_RC); const bf16* GK = GQ + (size_t)T * 256; const bf16* GV = GQ + (size_t)T * 512; const bf16* GG = GQ + (size_t)T * 1024;
        bf16* MIX = (bf16*)(ws + WS_RA);
        float lam; bool fastda;
        { int ln = my_tid(); asm volatile("" : "+v"(ln)); ln &= 63; const float a1 = wave_sum(args.in[6][ln] * args.in[7][ln]), a2 = wave_sum(args.in[8][ln] * args.in[9][ln]); lam = expf(a1) - expf(a2) + LAM_INIT;
          float gq = fabsf(args.in[4][ln]), gk = fabsf(args.in[5][ln]);
#pragma unroll
          for (int o = 1; o < 64; o <<= 1) { gq = fmaxf(gq, __shfl_xor(gq, o)); gk = fmaxf(gk, __shfl_xor(gk, o)); }
          fastda = __builtin_amdgcn_readfirstlane((int)(11.6f * gq * gk <= 32.f)) != 0; }
        unsigned char* QLG = ws + WS_RD; unsigned char* OIG = QLG + 16 * MiB; unsigned char* UG = OIG + 32 * MiB; float* DECG = (float*)(UG + 32 * MiB);
        gla2::prep_units(F.lds + RING_OFF, F.lds + XCH_OFF, (int)blockIdx.x, (int)F.G, 2048, GQ, GK, GV, (const float*)(ws + WS_GR), args.in[11], args.in[12], QLG, OIG, UG, DECG);
        xcd_barrier(bar);
        { OrderMN S; S.init(ws + WS_MN, 2048, ws + WS_WCKV, 2048, TM, 1024, F.G, (int)blockIdx.x - 64);
          EpiNorm256 E{(bf16*)(ws + WS_KC), 1024, args.in[20], nullptr, 1.f, xch};
          pg8::gemm_phase<EpiNorm256, OrderMN, false>(F.lds + RING_OFF, idxl, 2048, 2048, 1024, S, E, ws); }
        { OrderMN S; S.init(ws + WS_WCKV + (size_t)1024 * 2048, 2048, ws + WS_MN, 2048, 1024, TM, F.G, (int)blockIdx.x - 128);
          EpiPlain E{(bf16*)(ws + WS_VCT), 2048  };
          pg8::gemm_phase<EpiPlain, OrderMN, false>(F.lds + RING_OFF, idxl, 2048, 2048, 1024, S, E, ws); }
        bool have_ticket = false;
        for (;;) {
            if (!have_ticket) { int t0_ = my_tid(); asm volatile("" : "+v"(t0_)); if (t0_ == 448) MISC[4] = __hip_atomic_fetch_add((unsigned*)ctl + CW_Q, 1u, __ATOMIC_RELAXED, __HIP_MEMORY_SCOPE_AGENT); }
            have_ticket = false;
            asm volatile("s_waitcnt lgkmcnt(0)\n\ts_barrier" ::: "memory");
            const int kq = __builtin_amdgcn_readfirstlane((int)MISC[4]);
            asm volatile("s_waitcnt lgkmcnt(0)\n\ts_barrier" ::: "memory");
            if (kq >= 32 + 1024 + 256) break;
            if (kq >= 32 + 1024) { Frame F2 = F; refresh(F2); const int j = kq - 1056; conv8_tiles(args.in, ws, (LAS float*)(F.lds + RING_OFF), xch, F2.tid, j < 128 ? 2 * j : 128 + j, j < 128 ? 2 : 1); continue; }
            if (kq < 32) gla2::seq_unit(F.lds + RING_OFF, kq, GG, args.in[13], QLG, OIG, UG, DECG, MIX);
            else { const int k2 = kq - 32, qb = 31 - (k2 >> 5), bh = k2 & 31; if (fastda) da2::unit<true>(F.lds + RING_OFF, xch, bh >> 2, bh & 3, qb, DQ, DK, DV, MIX, lam, args.in[10], (unsigned*)ctl + CW_Q, MISC + 4); else da2::unit<false>(F.lds + RING_OFF, xch, bh >> 2, bh & 3, qb, DQ, DK, DV, MIX, lam, args.in[10], (unsigned*)ctl + CW_Q, MISC + 4);
                   have_ticket = true; }
        }
        if (BOTH(2)) xcd_barrier(bar);
    }
    bf16* H1B = (bf16*)(ws + WS_RB);
    bf16* QC = (bf16*)(ws + WS_RC);
    bf16* PB = (bf16*)(ws + WS_RD);
    bf16* OC = (bf16*)(ws + WS_RA);
    bf16* H2B = (bf16*)(ws + WS_RC);
    bf16* HID = (bf16*)(ws + WS_RD);
    bf16* YB = (bf16*)(ws + WS_RA);
    if (IN(3)) {
        OrderMN S; S.init(ws + WS_RA, 1024, ws + WS_WO, 1024, T, 1024, F.G, (int)blockIdx.x);
        EpiRes<false, true, true> E{args.in[0], H1B, (float*)(ws + WS_SSQ1), xch, 1.f, ws + WS_RB + 64 * MiB  , (const float*)(ws + WS_SBO)};
        pg8::gemm_phase<EpiRes<false, true, true>, OrderMN, false, true>(F.lds + RING_OFF, idxl, 1024, 1024, 512  , S, E, ws);
        if (BOTH(3)) xcd_barrier(bar);
    }
    if (IN(4)) {
        OrderPanel S{(const char*)(ws + WS_RB + 64 * MiB)  , (const char*)(ws + WS_WCQ)  , F.G, F.vcu  };
        EpiNorm256 E{QC, 1024, args.in[19], (const float*)(ws + WS_SSQ1), LOG2E  , xch};
        pg8::gemm_phase<EpiNorm256, OrderPanel, false, false, true>(F.lds + RING_OFF, idxl, 1024, 1024, 512  , S, E, ws);
        if (BOTH(4)) { asm volatile("s_waitcnt vmcnt(0)" ::: "memory"); __syncthreads(); }
    }
    if (IN(5)) {
        { OrderCross S{(const char*)QC, (const char*)(ws + WS_KC), 1024, 256 * 1024, 256, F.G, F.vcu  , 1024, 256  };
          EpiSoftmax E{PB, (float*)(ws + WS_RSUM), xch};
          pg8::gemm_phase<EpiSoftmax, OrderCross, false, false, true>(F.lds + RING_OFF, idxl, 1024, 1024, 128  , S, E, ws); }
        asm volatile("s_waitcnt vmcnt(0)" ::: "memory"); __syncthreads();
        { OrderCross S{(const char*)PB, (const char*)(ws + WS_VCT), 2048, 256, 256 * 2048, F.G, F.vcu  , 1024, 256  };
          EpiPV E{OC, (const float*)(ws + WS_RSUM)};
          pg8::gemm_phase<EpiPV, OrderCross, false, false, true>(F.lds + RING_OFF, idxl, 1024, 2048, 128  , S, E, ws); }
        if (BOTH(5)) xcd_barrier(bar);
    }
    if (IN(6)) {
        OrderMN S; S.init(OC, 1024, ws + WS_WCO, 1024, T, 1024, F.G, (int)blockIdx.x);
        EpiRes<true, true> E{H1B, H2B, (float*)(ws + WS_SSQ2), xch, 0.0625f, ws + WS_RA + 32 * MiB  };
        pg8::gemm_phase<EpiRes<true, true>, OrderMN, false, false, true>(F.lds + RING_OFF, idxl, 1024, 1024, 512  , S, E, ws);
        if (BOTH(6)) xcd_barrier(bar);
    }
    if (IN(7)) {
        { Frame F2 = F; refresh(F2); const int bx = (int)blockIdx.x;
          if (F2.tid < 128) { const int r_ = bx * 128 + F2.tid; const f32x4 q4 = *(const f32x4*)((const float*)(ws + WS_SSQ2) + (size_t)r_ * 4); ((float*)(ws + WS_RSTD))[r_] = rsqrtf(((q4[0] + q4[1]) + (q4[2] + q4[3])) * (1.f / D) + EPS); } }
        OrderMN S; S.init(H2B, 2048, ws + WS_WR, 2048, T, 256, F.G, (int)blockIdx.x);
        EpiRouter E{(const float*)(ws + WS_SSQ2), args.in[24], args.in[26], (unsigned*)(ws + WS_CTL) + CW_CNT, (int*)(ws + WS_LIST), (float*)(ws + WS_GATE), (float*)(ws + WS_RSTD), (int*)(ws + WS_TOKPOS), xch, (LAS unsigned*)(F.lds + TAB_OFF)};
        pg8::gemm_phase<EpiRouter, OrderMN, false>(F.lds + RING_OFF, idxl, 2048, 2048, 1024, S, E, ws);
        if (blockIdx.x >= 128) { Frame F2 = F; refresh(F2); const int w_ = (int)blockIdx.x - 128;
            conv8_tiles(args.in, ws, (LAS float*)(F.lds + RING_OFF), xch, F2.tid, 384 + 5 * w_, 5);
            conv_tiles(args.in, ws, (LAS float*)(F.lds + RING_OFF), F2.tid, 2048 + 2 * w_, 2); }
        if (BOTH(7)) xcd_barrier(bar);
    }
    if (IN(8)) {
        moe_table(F, ws);
        OrderMoe S{(const LAS int*)(F.lds + TAB_OFF), 0, 32, (const char*)(ws + WS_RA + 32 * MiB)  , (const char*)(ws + WS_WGU), (size_t)1024 * 1024, 1024, 1024, (const int*)(ws + WS_LIST), F.G, F.vcu  , true};
        EpiGU E{HID, (const int*)(ws + WS_LIST), (const float*)(ws + WS_RSTD), (const float*)(ws + WS_SBGU), xch};
        pg8::gemm_phase<EpiGU, OrderMoe, true, false, true>(F.lds + RING_OFF, idxl, 1024, 1024, 512  , S, E, ws);
        {
            const int nun = 4 * __builtin_amdgcn_readfirstlane(((const LAS int*)(F.lds + TAB_OFF))[32]), r = nun % F.G, n_idle = r ? F.G - r : 0;
            int first = 0, cnt = 0;
            if (n_idle >= 64) { if (F.vcu >= r) { const int per = (768 + n_idle - 1) / n_idle, idx = F.vcu - r; first = idx * per; cnt = 768 - first; cnt = cnt < 0 ? 0 : (cnt > per ? per : cnt); } }
            else { first = F.vcu * 3; cnt = 3; }
            Frame F2 = F; refresh(F2); __syncthreads();
            conv_tiles(args.in, ws, (LAS float*)(F.lds + RING_OFF), F2.tid, 2304 + first, cnt); }
        if (BOTH(8)) xcd_barrier(bar);
    }
    if (IN(9)) {
        moe_table(F, ws);
        OrderMoe S{(const LAS int*)(F.lds + TAB_OFF), 0, 32, (const char*)HID, (const char*)(ws + WS_WD), (size_t)1024 * 512, 512, 512, (const int*)(ws + WS_LIST), F.G, F.vcu  , false};
        EpiY E{YB, (const float*)(ws + WS_GATE), ws};
        pg8::gemm_phase<EpiY, OrderMoe, false, false, true>(F.lds + RING_OFF, idxl, 512, 512, 256  , S, E, ws);
        if (BOTH(9)) xcd_barrier(bar);
    }
    if (IN(10)) { moe_table(F, ws); p10_combine(F, H2B, YB, args.out, ws); }
#undef IN
#undef BOTH
}

extern "C" void kernel_launch(void* const* d_in, const int* in_sizes, int n_in, void* d_out, int out_size, void* d_ws, size_t ws_size, hipStream_t stream) {
    static int grid = 0;
    if (grid == 0) {
        if (n_in != 30 || out_size != T * D || ws_size < 512 * MiB) { fprintf(stderr, "kernel_launch: unexpected shapes (n_in %d out %d ws %zu)\n", n_in, out_size, ws_size); grid = -1; return; }
        int dev = 0, cus = 0, per_cu = 0;
        if (hipGetDevice(&dev) != hipSuccess || hipDeviceGetAttribute(&cus, hipDeviceAttributeMultiprocessorCount, dev) != hipSuccess) { grid = -1; return; }
        if (hipFuncSetAttribute((const void*)mega, hipFuncAttributeMaxDynamicSharedMemorySize, LDS_BYTES) != hipSuccess) { grid = -1; return; }
        if (hipOccupancyMaxActiveBlocksPerMultiprocessor(&per_cu, (const void*)mega, NWAVES * 64, LDS_BYTES) != hipSuccess || per_cu < 1) { fprintf(stderr, "kernel_launch: occupancy query says %d\n", per_cu); }
        (void)hipGetLastError();
        if (cus != 256) { fprintf(stderr, "kernel_launch: built for a 256-CU device (got %d); nothing launched\n", cus); grid = -1; return; }
        grid = cus;
    }
    if (grid < 0) return;
    (void)hipMemsetAsync((char*)d_ws + WS_CTL, 0, CTL_ZERO_BYTES, stream);
    Args a; memset(&a, 0, sizeof(a));
    for (int i = 0; i < 30; ++i) a.in[i] = (const float*)d_in[i];
    a.out = (float*)d_out; a.ws = (unsigned char*)d_ws; a.ph_lo = 0; a.ph_hi = 11;
    hipLaunchKernelGGL(mega, dim3(grid), dim3(NWAVES * 64), LDS_BYTES, stream, a);
}
```
